# Optimizing an MI355X kernel written in HIP

```python
import jax, jax.numpy as jnp
from jax import lax
import numpy as np

D_MODEL = 2048
BATCH = 4
SEQ = 4096
DEPTH = 2

GRID_W = 64
CTX_LEN = 256
MLA_HEADS = 16
Q_LORA = 512
KV_LORA = 256
NOPE_DIM = 128
ROPE_DIM = 64
V_DIM = 128
QK_DIM = NOPE_DIM + ROPE_DIM
ATTN_W = MLA_HEADS * V_DIM
ATTN_SCALE = QK_DIM ** -0.5
ROPE_BASE = 10000.0
Q_BLOCK = 128
CONV_CH = D_MODEL
CONV_K = 3
PEER_HEADS = 8
PEER_KEY_DIM = 256
PEER_HALF = PEER_KEY_DIM // 2
N_KEYS = 128
N_EXPERTS = N_KEYS * N_KEYS
PEER_TOPK = 16
TOKEN_BLOCK = 128
EPS = 1e-6
SPLIT_SIZES = (KV_LORA, ROPE_DIM, Q_LORA, CONV_CH, CONV_CH, CONV_CH, D_MODEL, D_MODEL)
KV_COLS = KV_LORA + ROPE_DIM
IN_COLS = KV_LORA + ROPE_DIM + Q_LORA + 3 * CONV_CH + 2 * D_MODEL

kernel_name = 'hybrid_mla_shortconv_peer_dit'


def rms_norm(x, gain):
    xf = x.astype(jnp.float32)
    y = xf * lax.rsqrt(jnp.mean(xf * xf, axis=-1, keepdims=True) + EPS)
    return (y * gain.astype(jnp.float32)).astype(x.dtype)


def modulate(h, shift, scale):
    return h * (1 + scale) + shift


def ada_params(cvec, w_mod, b_mod):
    return jnp.split(jax.nn.silu(cvec) @ w_mod + b_mod, 6, axis=-1)


def split_cols(p, sizes):
    outs, start = [], 0
    for s in sizes:
        outs.append(p[..., start:start + s])
        start += s
    return outs


def axial_rope(n_tokens):
    rows = n_tokens // GRID_W
    row = jnp.repeat(jnp.arange(rows), GRID_W).astype(jnp.float32)
    col = jnp.tile(jnp.arange(GRID_W), rows).astype(jnp.float32)
    half = ROPE_DIM // 2
    inv_freq = ROPE_BASE ** (-jnp.arange(0, half, 2, dtype=jnp.float32) / half)
    ang = jnp.concatenate([row[:, None] * inv_freq, col[:, None] * inv_freq], axis=-1)
    return jnp.cos(ang)[:, None, :], jnp.sin(ang)[:, None, :]


def apply_rope(x, cos, sin):
    x_nope, x_rot = x[..., :NOPE_DIM], x[..., NOPE_DIM:]
    x1, x2 = x_rot[..., 0::2], x_rot[..., 1::2]
    cos, sin = cos.astype(x.dtype), sin.astype(x.dtype)
    rot = jnp.stack([x1 * cos - x2 * sin, x1 * sin + x2 * cos], axis=-1).reshape(x_rot.shape)
    return jnp.concatenate([x_nope, rot], axis=-1)


def mla_kv(p_kv, p_kr, kv_a_norm, w_kv_up, k_norm, rope):
    b, s, _ = p_kv.shape
    kv = (rms_norm(p_kv, kv_a_norm) @ w_kv_up).reshape(b, s, MLA_HEADS, NOPE_DIM + V_DIM)
    k_rope = jnp.broadcast_to(p_kr[:, :, None, :], (b, s, MLA_HEADS, ROPE_DIM))
    k = rms_norm(jnp.concatenate([kv[..., :NOPE_DIM], k_rope], axis=-1), k_norm)
    if rope is not None:
        k = apply_rope(k, *rope)
    return k, kv[..., NOPE_DIM:]


def mla_q(p_q, q_a_norm, w_q_up, q_norm, rope):
    b, s, _ = p_q.shape
    q = (rms_norm(p_q, q_a_norm) @ w_q_up).reshape(b, s, MLA_HEADS, QK_DIM)
    q = rms_norm(q, q_norm)
    if rope is not None:
        q = apply_rope(q, *rope)
    return q


def softmax_attend(q, k, v):
    s = jnp.einsum('bqhd,bkhd->bhqk', q, k).astype(jnp.float32) * ATTN_SCALE
    p = jax.nn.softmax(s, axis=-1).astype(v.dtype)
    return jnp.einsum('bhqk,bkhd->bqhd', p, v)


def latent_attention(q, k_lat, v_lat, k_ctx, v_ctx):
    b, s, h, _ = q.shape
    k_all = jnp.concatenate([k_lat, k_ctx], axis=1)
    v_all = jnp.concatenate([v_lat, v_ctx], axis=1)
    q_blocks = jnp.moveaxis(q.reshape(b, s // Q_BLOCK, Q_BLOCK, h, QK_DIM), 1, 0)
    out = lax.map(lambda qb: softmax_attend(qb, k_all, v_all), q_blocks)
    return jnp.moveaxis(out, 0, 1).reshape(b, s, h * V_DIM)


def short_conv(b_gate, c_gate, u, conv_w):
    z = c_gate * u
    pad = CONV_K // 2
    zp = jnp.pad(z, ((0, 0), (pad, pad), (0, 0)))
    s = z.shape[1]
    y = sum(conv_w[j] * zp[:, j:j + s] for j in range(CONV_K))
    return b_gate * y


def merge_branches(attn, conv_parts, conv_w, w_attn_out, w_conv_out, w_o):
    b_gate, c_gate, u, g_a, g_c = conv_parts
    y_attn = attn @ w_attn_out
    y_conv = short_conv(b_gate, c_gate, u, conv_w) @ w_conv_out
    return (jax.nn.sigmoid(g_a) * y_attn + jax.nn.sigmoid(g_c) * y_conv) @ w_o


def peer_block(h, w_query, sub_keys, u_tab, v_tab):
    t = h.shape[0]
    q = (h @ w_query).reshape(t, PEER_HEADS, 2, PEER_HALF)
    s = jnp.einsum('thpd,hpnd->thpn', q, sub_keys)
    s_top, i_top = lax.top_k(s, PEER_TOPK)
    cand_s = (s_top[:, :, 0, :, None] + s_top[:, :, 1, None, :]).reshape(t, PEER_HEADS, PEER_TOPK * PEER_TOPK)
    cand_i = (i_top[:, :, 0, :, None] * N_KEYS + i_top[:, :, 1, None, :]).reshape(t, PEER_HEADS, PEER_TOPK * PEER_TOPK)
    best_s, pos = lax.top_k(cand_s, PEER_TOPK)
    idx = jnp.take_along_axis(cand_i, pos, axis=-1)
    g = jax.nn.softmax(best_s.astype(jnp.float32), axis=-1).astype(h.dtype)
    u = jnp.take(u_tab, idx, axis=0)
    a = jax.nn.gelu(jnp.einsum('thkd,td->thk', u, h), approximate=False)
    v = jnp.take(v_tab, idx, axis=0)
    return jnp.einsum('thk,thkd->td', g * a, v)


def peer(h, w_query, sub_keys, u_tab, v_tab):
    b, s, d = h.shape
    blocks = h.reshape(b * s // TOKEN_BLOCK, TOKEN_BLOCK, d)
    out = lax.map(lambda hb: peer_block(hb, w_query, sub_keys, u_tab, v_tab), blocks)
    return out.reshape(b, s, d)


def setup_inputs(seed: int = 0) -> dict:
    key = jax.random.key(seed)
    ks = jax.random.split(key, 24)
    L, D = DEPTH, D_MODEL

    def nrm(k, shape, scale):
        return jax.random.normal(k, shape, jnp.float32) * scale

    return {
        'x': nrm(ks[0], (BATCH, SEQ, D), 1.0),
        'c': nrm(ks[1], (BATCH, D), 1.0),
        'ctx': nrm(ks[2], (BATCH, CTX_LEN, D), 1.0),
        'c_ctx': nrm(ks[3], (D,), 1.0),
        'w_mod': nrm(ks[4], (L, D, 6 * D), 0.5 * D ** -0.5),
        'b_mod': nrm(ks[5], (L, 6 * D), 0.02),
        'ln_mix': 1.0 + nrm(ks[6], (L, D), 0.02),
        'w_in': nrm(ks[7], (L, D, IN_COLS), D ** -0.5),
        'q_a_norm': 1.0 + nrm(ks[8], (L, Q_LORA), 0.02),
        'kv_a_norm': 1.0 + nrm(ks[9], (L, KV_LORA), 0.02),
        'w_q_up': nrm(ks[10], (L, Q_LORA, MLA_HEADS * QK_DIM), Q_LORA ** -0.5),
        'w_kv_up': nrm(ks[11], (L, KV_LORA, MLA_HEADS * (NOPE_DIM + V_DIM)), KV_LORA ** -0.5),
        'q_norm': 1.0 + nrm(ks[12], (L, QK_DIM), 0.02),
        'k_norm': 1.0 + nrm(ks[13], (L, QK_DIM), 0.02),
        'conv_w': nrm(ks[14], (L, CONV_K, CONV_CH), CONV_K ** -0.5),
        'w_attn_out': nrm(ks[15], (L, ATTN_W, D), ATTN_W ** -0.5),
        'w_conv_out': nrm(ks[16], (L, CONV_CH, D), CONV_CH ** -0.5),
        'w_o': nrm(ks[17], (L, D, D), D ** -0.5),
        'ln_ffn': 1.0 + nrm(ks[18], (L, D), 0.02),
        'w_query': nrm(ks[19], (L, D, PEER_HEADS * PEER_KEY_DIM), D ** -0.5),
        'sub_keys': nrm(ks[20], (L, PEER_HEADS, 2, N_KEYS, PEER_HALF), PEER_HALF ** -0.5),
        'u_experts': nrm(ks[21], (L, N_EXPERTS, D), D ** -0.5),
        'v_experts': nrm(ks[22], (L, N_EXPERTS, D), PEER_HEADS ** -0.5),
    }


def reference(x, c, ctx, c_ctx, w_mod, b_mod, ln_mix, w_in, q_a_norm, kv_a_norm, w_q_up, w_kv_up,
              q_norm, k_norm, conv_w, w_attn_out, w_conv_out, w_o, ln_ffn, w_query, sub_keys,
              u_experts, v_experts):
    rope = axial_rope(x.shape[1])
    for l in range(DEPTH):
        last = l == DEPTH - 1
        sh1, sc1, g1, sh2, sc2, g2 = [m[:, None, :] for m in ada_params(c, w_mod[l], b_mod[l])]
        csh1, csc1, cg1, csh2, csc2, cg2 = ada_params(c_ctx, w_mod[l], b_mod[l])

        h_c = modulate(rms_norm(ctx, ln_mix[l]), csh1, csc1)
        if last:
            p_c = split_cols(h_c @ w_in[l][:, :KV_COLS], SPLIT_SIZES[:2])
        else:
            p_c = split_cols(h_c @ w_in[l], SPLIT_SIZES)
        k_c, v_c = mla_kv(p_c[0], p_c[1], kv_a_norm[l], w_kv_up[l], k_norm[l], None)

        h_x = modulate(rms_norm(x, ln_mix[l]), sh1, sc1)
        p_kv, p_kr, p_q, *conv_x = split_cols(h_x @ w_in[l], SPLIT_SIZES)
        k_x, v_x = mla_kv(p_kv, p_kr, kv_a_norm[l], w_kv_up[l], k_norm[l], rope)
        q_x = mla_q(p_q, q_a_norm[l], w_q_up[l], q_norm[l], rope)
        attn_x = latent_attention(q_x, k_x, v_x, k_c, v_c)
        x = x + g1 * merge_branches(attn_x, conv_x, conv_w[l], w_attn_out[l], w_conv_out[l], w_o[l])

        h2 = modulate(rms_norm(x, ln_ffn[l]), sh2, sc2)
        x = x + g2 * peer(h2, w_query[l], sub_keys[l], u_experts[l], v_experts[l])

        if not last:
            q_c = mla_q(p_c[2], q_a_norm[l], w_q_up[l], q_norm[l], None)
            attn_c = softmax_attend(q_c, k_c, v_c).reshape(ctx.shape[0], ctx.shape[1], ATTN_W)
            ctx = ctx + cg1 * merge_branches(attn_c, p_c[3:], conv_w[l], w_attn_out[l], w_conv_out[l], w_o[l])
            h2_c = modulate(rms_norm(ctx, ln_ffn[l]), csh2, csc2)
            ctx = ctx + cg2 * peer(h2_c, w_query[l], sub_keys[l], u_experts[l], v_experts[l])
    return x
```

```cpp
#include <hip/hip_runtime.h>
#include <cstdio>
#include <cstdint>
namespace pg8 {
#define PG8_LAS __attribute__((address_space(3)))
typedef unsigned short bf16_t;
typedef short bf16x8 __attribute__((ext_vector_type(8)));
typedef float f32x4 __attribute__((ext_vector_type(4)));
typedef unsigned u32x4 __attribute__((ext_vector_type(4)));
constexpr int BM = 256, BK = 64, HALF = 128, HTB = HALF * BK * 2  , STAGE_BYTES = 8 * HTB, NXCD = 8, WGM = 8;

__host__ __device__ __forceinline__ int lds_byte(int r, int c) { const int st = (r >> 4) * 2 + (c >> 5), rr = r & 15, cc = c & 31, ob = rr * 64 + cc * 2; return st * 1024 + (ob ^ (((ob >> 9) & 1) << 5)); }
__host__ __device__ __forceinline__ void stage_rc(int b, int& R, int& C) { const int st = b / 1024, sb = b % 1024, swz = sb ^ (((sb >> 9) & 1) << 5); R = (st >> 1) * 16 + swz / 64; C = (st & 1) * 32 + (swz % 64) / 2; }
__host__ __device__ __forceinline__ int perm32(int rho) { const int n = rho >> 4, i = rho & 15; return 8 * (i >> 2) + 4 * n + (i & 3); }

struct Unit { int pm, pn; };
struct Gemm { const bf16_t* A; const bf16_t* Bt; int M, N, K, lda, ldb; };

struct StaticOrder {
    int nM, nN, nwg, G, c;
    __host__ __device__ void init(int M, int N, int G_, int c_) { nM = M / BM; nN = N / BM; nwg = nM * nN; G = G_; c = c_; }
    __host__ __device__ bool next(int i, Unit& u) const {
        const long L = (long)i * G + c; if (L >= nwg) return false;
        int wgid = (int)L; { const int q = nwg / NXCD, r = nwg % NXCD, xcd = wgid % NXCD, off = wgid / NXCD; wgid = (xcd < r ? xcd * (q + 1) : r * (q + 1) + (xcd - r) * q) + off; }
        const int nig = WGM * nN, gid = wgid / nig, fm = gid * WGM, gsz = (nM - fm) < WGM ? (nM - fm) : WGM;
        u.pm = fm + ((wgid % nig) % gsz); u.pn = (wgid % nig) / gsz; return true;
    }
    __device__ __forceinline__ void a_ready(const Unit&) const {}
    __device__ __forceinline__ void done(const Unit&) const {}
};

__device__ __forceinline__ unsigned cvt_pk_bf16(float lo, float hi) { unsigned r; asm volatile("v_cvt_pk_bf16_f32 %0, %1, %2" : "=v"(r) : "v"(lo), "v"(hi)); return r; }
__device__ __forceinline__ float bf_lo(unsigned w) { return __uint_as_float(w << 16); }
__device__ __forceinline__ float bf_hi(unsigned w) { return __uint_as_float(w & 0xffff0000u); }
__device__ __forceinline__ float sigmoidf_(float x) { return __builtin_amdgcn_rcpf(1.0f + __expf(-x)); }
__device__ __forceinline__ u32x4 pack8(const f32x4 v0, const f32x4 v1) { u32x4 w; w.x = cvt_pk_bf16(v0[0], v0[1]); w.y = cvt_pk_bf16(v0[2], v0[3]); w.z = cvt_pk_bf16(v1[0], v1[1]); w.w = cvt_pk_bf16(v1[2], v1[3]); return w; }
constexpr float RMS_EPS = 1e-6f;

struct EpiP {
    static constexpr bool PERM = true, AFTER_DRAIN = false;
    bf16_t* O; int ldc; unsigned long long* ssq_kv; unsigned long long* ssq_q;
    __device__ __forceinline__ void operator()(const f32x4 (&acc)[2][2][4][2], const Unit& u, int wr, int wc, int fr, int fq) const {
        const int row0 = u.pm * BM + wr * 64 + fr, col0 = u.pn * BM + wc * 32 + 8 * fq;
        unsigned long long* ssq = (u.pn == 0) ? ssq_kv : ((u.pn == 2 || u.pn == 3) ? ssq_q : nullptr);
#pragma unroll
        for (int ai = 0; ai < 2; ++ai)
#pragma unroll
            for (int m = 0; m < 4; ++m) { const int row = row0 + ai * HALF + m * 16; bf16_t* rowp = O + (size_t)row * ldc + col0; float s = 0.f;
#pragma unroll
                for (int bj = 0; bj < 2; ++bj) { const f32x4 v0 = acc[ai][bj][m][0], v1 = acc[ai][bj][m][1];
                    s += (v0[0] * v0[0] + v0[1] * v0[1]) + (v0[2] * v0[2] + v0[3] * v0[3]) + (v1[0] * v1[0] + v1[1] * v1[1]) + (v1[2] * v1[2] + v1[3] * v1[3]);
                    *(u32x4*)(rowp + bj * HALF) = pack8(v0, v1); }
                if (ssq) { s += __shfl_xor(s, 16); s += __shfl_xor(s, 32); if (fq == 0) atomicAdd(ssq + row, (unsigned long long)(s * 1048576.0f)); } }
    }
};
__device__ __forceinline__ int key_row(int row) { return row < 16384 ? (row >> 12) * 4352 + (row & 4095) : ((row - 16384) >> 8) * 4352 + 4096 + ((row - 16384) & 255); }
struct EpiKV {
    static constexpr bool PERM = true, AFTER_DRAIN = false;
    bf16_t* KN; bf16_t* VA; const unsigned long long* ssq; int row_off;
    __device__ __forceinline__ void operator()(const f32x4 (&acc)[2][2][4][2], const Unit& u, int wr, int wc, int fr, int fq) const {
        const bool isv = u.pn >= 8;
        const int delta = u.pm < 64 ? (u.pm >> 4) * 256 : (u.pm - 64) * 4096 - 12288;
        char* base = isv ? (char*)(VA + (size_t)delta * 2048) : (char*)KN;
        const int rl = wr * 64 + fr;
        const unsigned off0 = ((unsigned)(u.pm * BM + rl) * 2048u + (unsigned)((u.pn & 7) * BM + wc * 32 + 8 * fq)) * 2u;
        const unsigned long long* sp = ssq + u.pm * BM;
#pragma unroll
        for (int ai = 0; ai < 2; ++ai)
#pragma unroll
            for (int m = 0; m < 4; ++m) { const float r = __builtin_amdgcn_rsqf((float)*(const unsigned long long*)((const char*)sp + (unsigned)(rl + ai * HALF + m * 16) * 8u) * (1.0f / (256.0f * 1048576.0f)) + RMS_EPS);
#pragma unroll
                for (int bj = 0; bj < 2; ++bj) *(u32x4*)(base + (off0 + (unsigned)((ai * HALF + m * 16) * 2048 + bj * HALF) * 2u)) = pack8(acc[ai][bj][m][0] * r, acc[ai][bj][m][1] * r); }
    }
};
struct EpiQ {
    static constexpr bool PERM = true, AFTER_DRAIN = false;
    bf16_t* QR; const unsigned long long* ssq;
    __device__ __forceinline__ void operator()(const f32x4 (&acc)[2][2][4][2], const Unit& u, int wr, int wc, int fr, int fq) const {
        const int rl = wr * 64 + fr;
        const unsigned off0 = ((unsigned)(u.pm * BM + rl) * 3072u + (unsigned)(u.pn * BM + wc * 32 + 8 * fq)) * 2u;
        const unsigned long long* sp = ssq + u.pm * BM;
#pragma unroll
        for (int ai = 0; ai < 2; ++ai)
#pragma unroll
            for (int m = 0; m < 4; ++m) { const float r = __builtin_amdgcn_rsqf((float)*(const unsigned long long*)((const char*)sp + (unsigned)(rl + ai * HALF + m * 16) * 8u) * (1.0f / (512.0f * 1048576.0f)) + RMS_EPS);
#pragma unroll
                for (int bj = 0; bj < 2; ++bj) *(u32x4*)((char*)QR + (off0 + (unsigned)((ai * HALF + m * 16) * 3072 + bj * HALF) * 2u)) = pack8(acc[ai][bj][m][0] * r, acc[ai][bj][m][1] * r); }
    }
};
template <bool ADD> struct EpiGate {
    static constexpr bool PERM = true, AFTER_DRAIN = false;
    bf16_t* Y; const bf16_t* Yin; const bf16_t* G; int ldg;
    __device__ __forceinline__ void operator()(const f32x4 (&acc)[2][2][4][2], const Unit& u, int wr, int wc, int fr, int fq) const {
        const int row0 = u.pm * BM + wr * 64 + fr, col0 = u.pn * BM + wc * 32 + 8 * fq;
#pragma unroll
        for (int ai = 0; ai < 2; ++ai)
#pragma unroll
            for (int m = 0; m < 4; ++m) { const int row = row0 + ai * HALF + m * 16;
#pragma unroll
                for (int bj = 0; bj < 2; ++bj) { const int col = col0 + bj * HALF;
                    const u32x4 g = *(const u32x4*)(G + (size_t)row * ldg + col); f32x4 v0 = acc[ai][bj][m][0], v1 = acc[ai][bj][m][1];
                    v0[0] *= sigmoidf_(bf_lo(g.x)); v0[1] *= sigmoidf_(bf_hi(g.x)); v0[2] *= sigmoidf_(bf_lo(g.y)); v0[3] *= sigmoidf_(bf_hi(g.y));
                    v1[0] *= sigmoidf_(bf_lo(g.z)); v1[1] *= sigmoidf_(bf_hi(g.z)); v1[2] *= sigmoidf_(bf_lo(g.w)); v1[3] *= sigmoidf_(bf_hi(g.w));
                    if (ADD) { const u32x4 y = *(const u32x4*)(Yin + (size_t)row * 2048 + col);
                        v0[0] += bf_lo(y.x); v0[1] += bf_hi(y.x); v0[2] += bf_lo(y.y); v0[3] += bf_hi(y.y); v1[0] += bf_lo(y.z); v1[1] += bf_hi(y.z); v1[2] += bf_lo(y.w); v1[3] += bf_hi(y.w); }
                    *(u32x4*)(Y + (size_t)row * 2048 + col) = pack8(v0, v1); } }
    }
};
struct EpiRes {
    static constexpr bool PERM = false, AFTER_DRAIN = false;
    const float* base; float* out; const float* gates;
    const float* cbase; float* cout;
    __device__ __forceinline__ void operator()(const f32x4 (&acc)[2][2][4][2], const Unit& u, int wr, int wc, int fr, int fq) const {
        const bool isc = u.pm >= 64; const int bi = isc ? 4 : (u.pm >> 4);
        const float* gp = gates + (size_t)bi * (6 * 2048) + 2 * 2048; const float* bp = isc ? cbase : base; float* op = isc ? cout : out;
        const int row0 = (isc ? (u.pm - 64) : u.pm) * BM + wr * 64 + fr, col0 = u.pn * BM + wc * 32 + 4 * fq;
        f32x4 gv[2][2];
#pragma unroll
        for (int bj = 0; bj < 2; ++bj)
#pragma unroll
            for (int n = 0; n < 2; ++n) gv[bj][n] = *(const f32x4*)(gp + col0 + bj * HALF + n * 16);
#pragma unroll
        for (int ai = 0; ai < 2; ++ai)
#pragma unroll
            for (int m = 0; m < 4; ++m) { const size_t off = (size_t)(row0 + ai * HALF + m * 16) * 2048 + col0;
#pragma unroll
                for (int bj = 0; bj < 2; ++bj)
#pragma unroll
                    for (int n = 0; n < 2; ++n) { const f32x4 b = *(const f32x4*)(bp + off + bj * HALF + n * 16); *(f32x4*)(op + off + bj * HALF + n * 16) = b + gv[bj][n] * acc[ai][bj][m][n]; } }
    }
};
struct EpiF32 {
    static constexpr bool PERM = false, AFTER_DRAIN = false;
    float* C; int ldc;
    __device__ __forceinline__ void operator()(const f32x4 (&acc)[2][2][4][2], const Unit& u, int wr, int wc, int fr, int fq) const {
        const int row0 = u.pm * BM + wr * 64 + fr, col0 = u.pn * BM + wc * 32 + 4 * fq;
#pragma unroll
        for (int ai = 0; ai < 2; ++ai)
#pragma unroll
            for (int m = 0; m < 4; ++m) { float* rowp = C + (size_t)(row0 + ai * HALF + m * 16) * ldc + col0;
#pragma unroll
                for (int bj = 0; bj < 2; ++bj)
#pragma unroll
                    for (int n = 0; n < 2; ++n) *(f32x4*)(rowp + bj * HALF + n * 16) = acc[ai][bj][m][n]; }
    }
};

template <class Epi, class Sched, bool ALIGN_EPI = false, bool SP2 = false>
__device__ __forceinline__ void gemm_phase(PG8_LAS unsigned char* lds, const Gemm g, const Sched& S, const Epi& E) {
    int tid_o = threadIdx.x; asm volatile("" : "+v"(tid_o));
    const int tid = tid_o, wid = __builtin_amdgcn_readfirstlane(tid >> 6), lane = tid & 63, wr = wid >> 2, wc = wid & 3, fr = lane & 15, fq = lane >> 4;
    int K_o = g.K; asm volatile("" : "+s"(K_o));
    const int K = K_o, nt = K / BK;
    unsigned voffA[2], voffB[2];
#pragma unroll
    for (int i = 0; i < 2; ++i) { int R, C; stage_rc(tid * 16 + i * 8192, R, C); const int Rb = Epi::PERM ? ((R & ~31) + perm32(R & 31)) : R;
        voffA[i] = (unsigned)(R * g.lda + C) * 2u; voffB[i] = (unsigned)(Rb * g.ldb + C) * 2u; }
    const size_t kstep = (size_t)(BK * 2);
    const size_t hstepA = (size_t)HALF * g.lda * 2, hstepB = (size_t)HALF * g.ldb * 2;
    const size_t tstepA = 2 * hstepA, tstepB = 2 * hstepB;
    const unsigned ldsw = (unsigned)wid * 1024u;
    const int aoff = lds_byte(wr * 64 + fr, fq * 8), boff = lds_byte(wc * 32 + fr, fq * 8);
#define PG8_SA(b, h) (((b) * 2 + (h)) * HTB)
#define PG8_SB(b, h) ((4 + (b) * 2 + (h)) * HTB)
#define PG8_STAGE(bufoff, gbase, voff) do { _Pragma("unroll") for (int _i = 0; _i < 2; ++_i) \
        __builtin_amdgcn_global_load_lds((const unsigned*)((const char*)(gbase) + (voff)[_i]), (PG8_LAS unsigned*)(lds + (bufoff) + ldsw + _i * 8192), 16, 0, 0); } while (0)
#define PG8_LDA(dst, b, h) do { _Pragma("unroll") for (int m = 0; m < 4; ++m) _Pragma("unroll") for (int k = 0; k < 2; ++k) dst[m][k] = *(const PG8_LAS bf16x8*)(lds + PG8_SA(b, h) + aoff + m * 2048 + k * 1024); } while (0)
#define PG8_LDB(dst, b, h) do { _Pragma("unroll") for (int n = 0; n < 2; ++n) _Pragma("unroll") for (int k = 0; k < 2; ++k) dst[n][k] = *(const PG8_LAS bf16x8*)(lds + PG8_SB(b, h) + boff + n * 2048 + k * 1024); } while (0)
#define PG8_MMA(ai, bj, At, Bt) do { __builtin_amdgcn_s_setprio(1); _Pragma("unroll") for (int m = 0; m < 4; ++m) _Pragma("unroll") for (int n = 0; n < 2; ++n) _Pragma("unroll") for (int k = 0; k < 2; ++k) \
        acc[ai][bj][m][n] = __builtin_amdgcn_mfma_f32_16x16x32_bf16(Bt[n][k], At[m][k], acc[ai][bj][m][n], 0, 0, 0); __builtin_amdgcn_s_setprio(0); } while (0)
#define PG8_WAIT_V(n) asm volatile("s_waitcnt vmcnt(" #n ")" ::: "memory")
#define PG8_WAIT_L(n) asm volatile("s_waitcnt lgkmcnt(" #n ")" ::: "memory")
#define PG8_BAR __builtin_amdgcn_s_barrier()
#define PG8_SCHED __builtin_amdgcn_sched_barrier(0)
    Unit cur, nxt; int ui = 0;
    if (!S.next(0, cur)) return;
    f32x4 acc[2][2][4][2];
#pragma unroll
    for (int a = 0; a < 2; ++a)
#pragma unroll
        for (int b = 0; b < 2; ++b)
#pragma unroll
            for (int m = 0; m < 4; ++m)
#pragma unroll
                for (int n = 0; n < 2; ++n) acc[a][b][m][n] = (f32x4){0.f, 0.f, 0.f, 0.f};
    bf16x8 At[4][2], B0[2][2], B1[2][2];
    const char* cA = (const char*)g.A + (size_t)cur.pm * tstepA; const char* cB = (const char*)g.Bt + (size_t)cur.pn * tstepB;
    S.a_ready(cur);
    if constexpr (SP2) {
        PG8_STAGE(PG8_SB(0, 0), cB, voffB); PG8_STAGE(PG8_SB(0, 1), cB + hstepB, voffB); PG8_STAGE(PG8_SA(0, 0), cA, voffA); PG8_STAGE(PG8_SA(0, 1), cA + hstepA, voffA);
        if (wr == 1) PG8_BAR;
        PG8_WAIT_V(2); PG8_BAR;
        PG8_STAGE(PG8_SB(1, 0), cB + kstep, voffB); PG8_STAGE(PG8_SA(1, 0), cA + kstep, voffA); PG8_STAGE(PG8_SB(1, 1), cB + hstepB + kstep, voffB);
        PG8_WAIT_V(6); PG8_BAR;
    } else {
        PG8_STAGE(PG8_SB(0, 0), cB, voffB); PG8_STAGE(PG8_SA(0, 0), cA, voffA); PG8_STAGE(PG8_SB(0, 1), cB + hstepB, voffB); PG8_STAGE(PG8_SA(0, 1), cA + hstepA, voffA);
        if (wr == 1) PG8_BAR;
        PG8_WAIT_V(4); PG8_BAR;
        PG8_STAGE(PG8_SB(1, 0), cB + kstep, voffB); PG8_STAGE(PG8_SA(1, 0), cA + kstep, voffA); PG8_STAGE(PG8_SB(1, 1), cB + hstepB + kstep, voffB);
        PG8_WAIT_V(6); PG8_BAR;
    }
    for (;;) {
        const bool has_next = S.next(ui + 1, nxt);
        const char* nA = has_next ? (const char*)g.A + (size_t)nxt.pm * tstepA : cA; const char* nB = has_next ? (const char*)g.Bt + (size_t)nxt.pn * tstepB : cB;
        for (int t = 0; t < nt; t += 2) {
            const bool last = (t == nt - 2);
            const char* a1 = cA + (size_t)(t + 1) * kstep;
            const char* a2 = last ? nA : cA + (size_t)(t + 2) * kstep; const char* b2 = last ? nB : cB + (size_t)(t + 2) * kstep;
            const char* a3 = a2 + kstep; const char* b3 = b2 + kstep;
            if (last && has_next) S.a_ready(nxt);
            if constexpr (SP2) {
            PG8_LDB(B0, 0, 0); PG8_LDB(B1, 0, 1); PG8_SCHED; PG8_LDA(At, 0, 0); PG8_STAGE(PG8_SA(1, 1), a1 + hstepA, voffA);
            PG8_WAIT_V(8); PG8_WAIT_L(0); PG8_BAR; PG8_MMA(0, 0, At, B0); PG8_MMA(0, 1, At, B1); PG8_BAR; PG8_SCHED;
            PG8_LDA(At, 0, 1); PG8_STAGE(PG8_SB(0, 0), b2, voffB); PG8_STAGE(PG8_SB(0, 1), b2 + hstepB, voffB); PG8_STAGE(PG8_SA(0, 0), a2, voffA);
            PG8_WAIT_V(8); PG8_WAIT_L(0); PG8_BAR; PG8_MMA(1, 0, At, B0); PG8_MMA(1, 1, At, B1); PG8_BAR; PG8_SCHED;
            PG8_LDB(B0, 1, 0); PG8_LDB(B1, 1, 1); PG8_SCHED; PG8_LDA(At, 1, 0); PG8_STAGE(PG8_SA(0, 1), a2 + hstepA, voffA);
            PG8_WAIT_V(8); PG8_WAIT_L(0); PG8_BAR; PG8_MMA(0, 0, At, B0); PG8_MMA(0, 1, At, B1); PG8_BAR; PG8_SCHED;
            PG8_LDA(At, 1, 1); PG8_STAGE(PG8_SB(1, 0), b3, voffB); PG8_STAGE(PG8_SB(1, 1), b3 + hstepB, voffB); PG8_STAGE(PG8_SA(1, 0), a3, voffA);
            PG8_WAIT_V(8); PG8_WAIT_L(0); PG8_BAR; PG8_MMA(1, 0, At, B0); PG8_MMA(1, 1, At, B1); PG8_BAR; PG8_SCHED;
            } else {
            PG8_LDB(B0, 0, 0); PG8_SCHED; PG8_LDA(At, 0, 0); PG8_STAGE(PG8_SA(1, 1), a1 + hstepA, voffA);
            PG8_WAIT_L(8); PG8_BAR; PG8_WAIT_L(0); PG8_MMA(0, 0, At, B0); PG8_BAR; PG8_SCHED;
            PG8_LDB(B1, 0, 1); PG8_STAGE(PG8_SB(0, 0), b2, voffB);
            PG8_BAR; PG8_WAIT_L(0); PG8_MMA(0, 1, At, B1); PG8_BAR;
            PG8_LDA(At, 0, 1); PG8_STAGE(PG8_SA(0, 0), a2, voffA);
            PG8_BAR; PG8_WAIT_L(0); PG8_MMA(1, 0, At, B0); PG8_BAR; PG8_SCHED;
            PG8_STAGE(PG8_SB(0, 1), b2 + hstepB, voffB);
            PG8_WAIT_V(6); PG8_BAR; PG8_MMA(1, 1, At, B1); PG8_BAR;
            PG8_LDB(B0, 1, 0); PG8_SCHED; PG8_LDA(At, 1, 0); PG8_STAGE(PG8_SA(0, 1), a2 + hstepA, voffA);
            PG8_WAIT_L(8); PG8_BAR; PG8_WAIT_L(0); PG8_MMA(0, 0, At, B0); PG8_BAR; PG8_SCHED;
            PG8_LDB(B1, 1, 1); PG8_STAGE(PG8_SB(1, 0), b3, voffB);
            PG8_BAR; PG8_WAIT_L(0); PG8_MMA(0, 1, At, B1); PG8_BAR;
            PG8_LDA(At, 1, 1); PG8_STAGE(PG8_SA(1, 0), a3, voffA);
            PG8_BAR; PG8_WAIT_L(0); PG8_MMA(1, 0, At, B0); PG8_BAR; PG8_SCHED;
            PG8_STAGE(PG8_SB(1, 1), b3 + hstepB, voffB);
            PG8_WAIT_V(6); PG8_BAR; PG8_MMA(1, 1, At, B1); PG8_BAR;
            }
        }
        if constexpr (ALIGN_EPI) { if (wr == 0) PG8_BAR; }
        if constexpr (!Epi::AFTER_DRAIN) { E(acc, cur, wr, wc, fr, fq); S.done(cur); }
        if (!has_next) break;
#pragma unroll
        for (int a = 0; a < 2; ++a)
#pragma unroll
            for (int b = 0; b < 2; ++b)
#pragma unroll
                for (int m = 0; m < 4; ++m)
#pragma unroll
                    for (int n = 0; n < 2; ++n) acc[a][b][m][n] = (f32x4){0.f, 0.f, 0.f, 0.f};
        cur = nxt; cA = nA; cB = nB; ++ui;
        if constexpr (ALIGN_EPI) { if (wr == 1) PG8_BAR; }
    }
    PG8_WAIT_V(0);
    if constexpr (!ALIGN_EPI) { if (wr == 0) PG8_BAR; }
    PG8_BAR;
    if constexpr (Epi::AFTER_DRAIN) { E.fused(acc, cur, wr, wc, fr, fq, lds, wid, lane); S.done(cur); }
#undef PG8_SA
#undef PG8_SB
#undef PG8_STAGE
#undef PG8_LDA
#undef PG8_LDB
#undef PG8_MMA
#undef PG8_WAIT_V
#undef PG8_WAIT_L
#undef PG8_BAR
#undef PG8_SCHED
}
}
namespace att {
using bf16x8 = __attribute__((ext_vector_type(8))) short;
using s16x4  = __attribute__((ext_vector_type(4))) short;
using f32x16 = __attribute__((ext_vector_type(16))) float;
using u32x4  = __attribute__((ext_vector_type(4))) unsigned;
typedef unsigned short bf16_t;
constexpr int DQK = 192, DV = 128, NW = 8, QBLK = 32, KVBLK = 64, ND0 = DQK / 16;
constexpr float SCALE = 0.07216878364870322f;
constexpr float THR = 8.f;
constexpr int LDQ = 3072, LDK = 3072, LDV = 2048, LDO = 2048;
constexpr int SHM_V = KVBLK * DV * 2, SHM_K = KVBLK * DQK * 2, SHM_WS = 2 * SHM_V + 2 * SHM_K, SHM_QR = SHM_WS + NW * 64 * 4, SHM_ATTN = SHM_QR + NW * 4096;
#define ATT_KSWZ(row, colB) ((row) * 384 + ((colB) ^ (((row) & 7) << 4)))
#define ATT_SBAR() __builtin_amdgcn_sched_barrier(0)
__device__ __forceinline__ int crow(int r, int hi) { return (r & 3) + 8 * (r >> 2) + 4 * hi; }
__device__ __forceinline__ unsigned cvtpk(float lo, float hi) { unsigned r; asm volatile("v_cvt_pk_bf16_f32 %0, %1, %2" : "=v"(r) : "v"(lo), "v"(hi)); return r; }
__device__ __forceinline__ void partialSM(f32x16& p0, f32x16& p1, float& m_reg, float& mn, float& alpha) {
  constexpr float C = SCALE * 1.4426950408889634f;
  float pmax = p0[0];
#pragma unroll
  for (int r = 1; r < 16; ++r) pmax = fmaxf(pmax, p0[r]);
#pragma unroll
  for (int r = 0; r < 16; ++r) pmax = fmaxf(pmax, p1[r]);
  { auto rr = __builtin_amdgcn_permlane32_swap(__float_as_uint(pmax), __float_as_uint(pmax), false, false);
    pmax = fmaxf(__uint_as_float(rr[0]), __uint_as_float(rr[1])); }
  if (__builtin_expect(__all(pmax - m_reg <= THR / SCALE), 1)) { mn = m_reg; alpha = 1.f; }
  else { mn = fmaxf(m_reg, pmax); alpha = __builtin_amdgcn_exp2f((m_reg - mn) * C); m_reg = mn; }
  float mnC = -mn * C;
#pragma unroll
  for (int r = 0; r < 16; ++r) p0[r] = fmaf(p0[r], C, mnC);
#pragma unroll
  for (int r = 0; r < 16; ++r) p1[r] = fmaf(p1[r], C, mnC);
#pragma unroll
  for (int r = 0; r < 16; ++r) p0[r] = __builtin_amdgcn_exp2f(p0[r]);
}
__device__ __forceinline__ void finishSM(f32x16& p0, f32x16& p1, float alpha, float& l_reg, bf16x8& pa0, bf16x8& pa1, bf16x8& pa2, bf16x8& pa3) {
#pragma unroll
  for (int r = 0; r < 16; ++r) p1[r] = __builtin_amdgcn_exp2f(p1[r]);
  float ps = 0;
#pragma unroll
  for (int r = 0; r < 16; ++r) ps += p0[r];
#pragma unroll
  for (int r = 0; r < 16; ++r) ps += p1[r];
  { auto rr = __builtin_amdgcn_permlane32_swap(__float_as_uint(ps), __float_as_uint(ps), false, false);
    ps = __uint_as_float(rr[0]) + __uint_as_float(rr[1]); }
  l_reg = l_reg * alpha + ps;
#define ATT_PK4(P, BASE, OUT) do { unsigned a0 = cvtpk(P[BASE + 0], P[BASE + 1]), a1 = cvtpk(P[BASE + 2], P[BASE + 3]);   \
    unsigned b0 = cvtpk(P[BASE + 4], P[BASE + 5]), b1 = cvtpk(P[BASE + 6], P[BASE + 7]);                              \
    auto r0 = __builtin_amdgcn_permlane32_swap(a0, b0, false, false); auto r1 = __builtin_amdgcn_permlane32_swap(a1, b1, false, false); \
    u32x4 w = {r0[0], r1[0], r0[1], r1[1]}; OUT = *reinterpret_cast<bf16x8*>(&w); } while (0)
  ATT_PK4(p0, 0, pa0); ATT_PK4(p0, 8, pa1); ATT_PK4(p1, 0, pa2); ATT_PK4(p1, 8, pa3);
#undef ATT_PK4
}
__device__ __forceinline__ void qkt(f32x16& p0, f32x16& p1, const char* Ks, const bf16x8* qr, const char* qrl, int r32, int hi) {
  p0 = f32x16{}; p1 = f32x16{};
#pragma unroll
  for (int d0 = 0; d0 < ND0; ++d0) { const int cb = (d0 * 16 + hi * 8) * 2;
    bf16x8 b0 = *reinterpret_cast<const bf16x8*>(Ks + ATT_KSWZ(r32, cb));
    bf16x8 b1 = *reinterpret_cast<const bf16x8*>(Ks + ATT_KSWZ(32 + r32, cb));
    const bf16x8 q = (d0 < 8) ? qr[d0 < 8 ? d0 : 0] : *reinterpret_cast<const bf16x8*>(qrl + (d0 - 8) * 1024);
    p0 = __builtin_amdgcn_mfma_f32_32x32x16_bf16(b0, q, p0, 0, 0, 0);
    p1 = __builtin_amdgcn_mfma_f32_32x32x16_bf16(b1, q, p1, 0, 0, 0); }
}
__device__ __forceinline__ int v_st(int k, int c) { const int kk = (k & ~0xC) | ((k & 4) << 1) | ((k & 8) >> 1); return ((kk >> 3) * 4 + (c >> 5)) * 512 + ((kk & 7) * 32 + (c & 31)) * 2; }
__device__ __forceinline__ int v_rd_base(int lane) { return ((lane & 3) << 3) | (((lane >> 2) & 3) << 6) | (((lane >> 4) & 1) << 5) | (((lane >> 5) & 1) << 8); }
constexpr int v_rd_off(int d0, int ks, int half) { return d0 * 512 + ks * 4096 + half * 2048; }
template <int OFF> __device__ __forceinline__ s16x4 tr_read(int vb) {
  s16x4 r; asm volatile("ds_read_b64_tr_b16 %0, %1 offset:%2" : "=&v"(r) : "v"(vb), "i"(OFF) : "memory"); return r;
}
template <int D0> __device__ __forceinline__ void pv_one(f32x16& od, int vb, bf16x8 pa0, bf16x8 pa1, bf16x8 pa2, bf16x8 pa3) {
  const s16x4 l0 = tr_read<v_rd_off(D0, 0, 0)>(vb), h0 = tr_read<v_rd_off(D0, 0, 1)>(vb), l1 = tr_read<v_rd_off(D0, 1, 0)>(vb), h1 = tr_read<v_rd_off(D0, 1, 1)>(vb);
  const s16x4 l2 = tr_read<v_rd_off(D0, 2, 0)>(vb), h2 = tr_read<v_rd_off(D0, 2, 1)>(vb), l3 = tr_read<v_rd_off(D0, 3, 0)>(vb), h3 = tr_read<v_rd_off(D0, 3, 1)>(vb);
  asm volatile("s_waitcnt lgkmcnt(0)" ::: "memory"); ATT_SBAR();
#define ATT_PK(L, H) (bf16x8){L[0], L[1], L[2], L[3], H[0], H[1], H[2], H[3]}
  od = __builtin_amdgcn_mfma_f32_32x32x16_bf16(pa0, ATT_PK(l0, h0), od, 0, 0, 0);
  od = __builtin_amdgcn_mfma_f32_32x32x16_bf16(pa1, ATT_PK(l1, h1), od, 0, 0, 0);
  od = __builtin_amdgcn_mfma_f32_32x32x16_bf16(pa2, ATT_PK(l2, h2), od, 0, 0, 0);
  od = __builtin_amdgcn_mfma_f32_32x32x16_bf16(pa3, ATT_PK(l3, h3), od, 0, 0, 0);
#undef ATT_PK
}
__device__ __forceinline__ void pv_d0(f32x16* o, int vb, bf16x8 pa0, bf16x8 pa1, bf16x8 pa2, bf16x8 pa3) {
  pv_one<0>(o[0], vb, pa0, pa1, pa2, pa3); pv_one<1>(o[1], vb, pa0, pa1, pa2, pa3); pv_one<2>(o[2], vb, pa0, pa1, pa2, pa3); pv_one<3>(o[3], vb, pa0, pa1, pa2, pa3);
}
__device__ __forceinline__ void attn_unit(const bf16_t* __restrict__ Qb, const bf16_t* __restrict__ Kh, const bf16_t* __restrict__ Vh, bf16_t* __restrict__ Ob, int seq, char* lds) {
  int tid_o = threadIdx.x; asm volatile("" : "+v"(tid_o));
  const int tid = tid_o, wid = tid >> 6, lane = tid & 63, r32 = lane & 31, hi = lane >> 5;
  char* V_lds = lds; char* K_lds = lds + 2 * SHM_V;
  float* ws = (float*)(lds + SHM_WS) + wid * 64; char* qrl = lds + SHM_QR + wid * 4096 + lane * 16; float* li_l = ws; float* al_l = ws + 32;
  float m_reg = -1e30f, l_reg = 0; f32x16 o[4] = {}; bf16x8 qr[8];
  const bf16_t* Qw = Qb + (long)(wid * QBLK + r32) * LDQ + hi * 8;
#pragma unroll
  for (int d0 = 0; d0 < 8; ++d0) qr[d0] = *reinterpret_cast<const bf16x8*>(Qw + d0 * 16);
#pragma unroll
  for (int d0 = 8; d0 < ND0; ++d0) *reinterpret_cast<bf16x8*>(qrl + (d0 - 8) * 1024) = *reinterpret_cast<const bf16x8*>(Qw + d0 * 16);
  const int sr = tid >> 4, sc = (tid & 15) * 8, vst0 = v_st(sr, sc), vst1 = vst0 + 8192;
  const int kst0 = ATT_KSWZ(sr, sc * 2), kr2 = tid >> 3, kc2 = 128 + (tid & 7) * 8, kst2 = ATT_KSWZ(kr2, kc2 * 2);
  const int vb0 = (int)(uintptr_t)V_lds + v_rd_base(lane);
  bf16x8 vs0, vs1, ks0, ks1, ks2;
  const unsigned voff0 = (unsigned)(sr * LDV + sc) * 2u, koff0 = (unsigned)(sr * LDK + sc) * 2u, koff2 = (unsigned)(kr2 * LDK + kc2) * 2u;
#define ATT_SLOAD(k0) do { const char* vt_ = (const char*)Vh + (size_t)(k0) * (LDV * 2); const char* kt_ = (const char*)Kh + (size_t)(k0) * (LDK * 2); \
    vs0 = *reinterpret_cast<const bf16x8*>(vt_ + voff0); vs1 = *reinterpret_cast<const bf16x8*>(vt_ + 32 * LDV * 2 + voff0); \
    ks0 = *reinterpret_cast<const bf16x8*>(kt_ + koff0); ks1 = *reinterpret_cast<const bf16x8*>(kt_ + 32 * LDK * 2 + koff0); \
    ks2 = *reinterpret_cast<const bf16x8*>(kt_ + koff2); } while (0)
#define ATT_SWRITE(b) do { *(bf16x8*)(V_lds + (b) * SHM_V + vst0) = vs0; *(bf16x8*)(V_lds + (b) * SHM_V + vst1) = vs1; \
    *(bf16x8*)(K_lds + (b) * SHM_K + kst0) = ks0; *(bf16x8*)(K_lds + (b) * SHM_K + kst0 + 32 * 384) = ks1; *(bf16x8*)(K_lds + (b) * SHM_K + kst2) = ks2; } while (0)
#define ATT_SWAIT() asm volatile("s_waitcnt vmcnt(0)" ::: "memory")
#define ATT_RESC(a) do { if (__any((a) < 1.f)) { if (hi == 0) al_l[r32] = (a); asm volatile("s_waitcnt lgkmcnt(0)" ::: "memory"); \
    _Pragma("unroll") for (int d = 0; d < 4; ++d) _Pragma("unroll") for (int r = 0; r < 16; ++r) o[d][r] *= al_l[crow(r, hi)]; } } while (0)
  f32x16 pA0, pA1, pB0, pB1; float mnA, mnB, alA, alB; bf16x8 pa0, pa1, pa2, pa3; const int NT = seq / KVBLK;
  ATT_SLOAD(0); ATT_SWAIT(); ATT_SWRITE(0); __syncthreads();
  qkt(pA0, pA1, K_lds, qr, qrl, r32, hi); partialSM(pA0, pA1, m_reg, mnA, alA);
  ATT_SLOAD(KVBLK);
  ATT_SWAIT(); ATT_SWRITE(1); __syncthreads();
  for (int j = 1; j + 1 < NT; j += 2) {
    ATT_SBAR(); qkt(pB0, pB1, K_lds + SHM_K, qr, qrl, r32, hi);
    finishSM(pA0, pA1, alA, l_reg, pa0, pa1, pa2, pa3); ATT_SBAR();
    ATT_SLOAD((j + 1) * KVBLK); ATT_SBAR();
    pv_d0(o, vb0, pa0, pa1, pa2, pa3); partialSM(pB0, pB1, m_reg, mnB, alB);
    __syncthreads(); ATT_SWAIT(); ATT_SWRITE(0);
    ATT_RESC(alB); __syncthreads();
    ATT_SBAR(); qkt(pA0, pA1, K_lds, qr, qrl, r32, hi);
    finishSM(pB0, pB1, alB, l_reg, pa0, pa1, pa2, pa3); ATT_SBAR();
    ATT_SLOAD((j + 2) * KVBLK); ATT_SBAR();
    pv_d0(o, vb0 + SHM_V, pa0, pa1, pa2, pa3); partialSM(pA0, pA1, m_reg, mnA, alA);
    __syncthreads(); ATT_SWAIT(); ATT_SWRITE(1);
    ATT_RESC(alA); __syncthreads();
  }
  ATT_SBAR(); qkt(pB0, pB1, K_lds + SHM_K, qr, qrl, r32, hi);
  finishSM(pA0, pA1, alA, l_reg, pa0, pa1, pa2, pa3); ATT_SBAR();
  pv_d0(o, vb0, pa0, pa1, pa2, pa3); partialSM(pB0, pB1, m_reg, mnB, alB);
  __syncthreads(); ATT_RESC(alB);
  finishSM(pB0, pB1, alB, l_reg, pa0, pa1, pa2, pa3); ATT_SBAR();
  pv_d0(o, vb0 + SHM_V, pa0, pa1, pa2, pa3);
  if (hi == 0) li_l[r32] = l_reg; asm volatile("s_waitcnt lgkmcnt(0)" ::: "memory");
  float rli[16];
#pragma unroll
  for (int r = 0; r < 16; ++r) rli[r] = __builtin_amdgcn_rcpf(li_l[crow(r, hi)]);
  bf16_t* Ow = Ob + (long)(wid * QBLK) * LDO;
#pragma unroll
  for (int r = 0; r < 16; ++r) { const int orow = crow(r, hi);
#pragma unroll
    for (int d0 = 0; d0 < 4; ++d0) { const float a = o[d0][r] * rli[r]; const float bq = __shfl_xor(a, 1);
      if (!(lane & 1)) *(unsigned*)(Ow + (long)orow * LDO + d0 * 32 + r32) = cvtpk(a, bq); } }
  __syncthreads();
#undef ATT_SLOAD
#undef ATT_SWRITE
#undef ATT_SWAIT
#undef ATT_RESC
}
#undef ATT_SBAR
}
#define LAS __attribute__((address_space(3)))
#define XB_TMO      128
#define XB_XCNT(j)  (256  + 64 * (j))
#define XB_XSUB(j)  (1280 + 64 * (j))
#define XB_XGEN(j)  (2304 + 64 * (j))
#define XB_TOP      3328
#define XB_TOPGEN   3392
#define XCD_BAR_WORDS 3456
#define XB_SPIN_CAP (1u << 18)

__device__ __forceinline__ unsigned xb_ld(unsigned* p)              { return __hip_atomic_load(p, __ATOMIC_RELAXED, __HIP_MEMORY_SCOPE_AGENT); }
__device__ __forceinline__ unsigned xb_add(unsigned* p, unsigned v) { return __hip_atomic_fetch_add(p, v, __ATOMIC_RELAXED, __HIP_MEMORY_SCOPE_AGENT); }
__device__ __forceinline__ unsigned xb_xcc_id() { return (unsigned)__builtin_amdgcn_s_getreg((3 << 11) | 20) & 0xFu; }
#define XB_SPIN(cond, bar) do { unsigned _sp = 0; while (cond) { __builtin_amdgcn_s_sleep(1); \
    if ((++_sp & 255u) == 0u) { if (xb_ld(&(bar)[XB_TMO])) break; if (_sp > XB_SPIN_CAP) { atomicAdd(&(bar)[XB_TMO], 1u); break; } } } } while (0)

struct XcdBarrier {
    unsigned* bar; unsigned x;
    volatile LAS unsigned* st;
};

__device__ __forceinline__ XcdBarrier xcd_barrier_post(unsigned* bar, volatile LAS unsigned* st) {
    XcdBarrier b; b.bar = bar; b.x = xb_xcc_id(); b.st = st;
    if (threadIdx.x == 0) (void)xb_add(&bar[XB_XCNT(b.x)], 1u);
    return b;
}
__device__ __forceinline__ void xcd_barrier_complete(unsigned* bar, unsigned x, unsigned& nloc, unsigned& nx) {
    const unsigned G = gridDim.x * gridDim.y * gridDim.z;
    unsigned sum, cnt, mine, sp = 0u;
    for (;;) {
        sum = 0u; cnt = 0u; mine = 0u;
#pragma unroll
        for (unsigned j = 0; j < 16; ++j) { const unsigned c = xb_ld(&bar[XB_XCNT(j)]); sum += c; cnt += (c > 0u) ? 1u : 0u; mine = (j == x) ? c : mine; }
        if (sum == G) break;
        __builtin_amdgcn_s_sleep(1);
        if ((++sp & 255u) == 0u) { if (xb_ld(&bar[XB_TMO])) break; if (sp > XB_SPIN_CAP) { atomicAdd(&bar[XB_TMO], 1u); break; } }
    }
    nloc = mine > 0u ? mine : 1u; nx = cnt > 0u ? cnt : 1u;
}

__device__ __forceinline__ void xcd_barrier(const XcdBarrier& b) {
    asm volatile("s_waitcnt vmcnt(0)" ::: "memory");
    __syncthreads();
    if (threadIdx.x == 0) {
        unsigned* bar = b.bar;
        __builtin_amdgcn_s_waitcnt(0);
        unsigned nloc = b.st[0], nx = b.st[1];
        if (nloc == 0u) { xcd_barrier_complete(bar, b.x, nloc, nx); b.st[0] = nloc; b.st[1] = nx; }
        const unsigned old = xb_add(&bar[XB_XSUB(b.x)], 1u);
        const unsigned gen = old / nloc;
        if (old + 1u == (gen + 1u) * nloc) {
            __builtin_amdgcn_fence(__ATOMIC_RELEASE, "agent");
            asm volatile("s_waitcnt vmcnt(0)" ::: "memory");
            const unsigned og = xb_add(&bar[XB_TOP], 1u);
            const unsigned tg = og / nx;
            if (og + 1u == (tg + 1u) * nx) xb_add(&bar[XB_TOPGEN], 1u);
            else XB_SPIN(xb_ld(&bar[XB_TOPGEN]) == tg, bar);
            __builtin_amdgcn_fence(__ATOMIC_ACQUIRE, "agent");
            xb_add(&bar[XB_XGEN(b.x)], 1u);
            asm volatile("s_waitcnt vmcnt(0)" ::: "memory");
        } else {
            XB_SPIN(xb_ld(&bar[XB_XGEN(b.x)]) == gen, bar);
            __builtin_amdgcn_fence(__ATOMIC_ACQUIRE, "agent");
            asm volatile("s_waitcnt vmcnt(0)" ::: "memory");
        }
    }
    __syncthreads();
}

constexpr int NWAVES = 8;
constexpr int DM = 2048, NB = 4, SEQ = 4096, CTXL = 256, NLAYER = 2;
constexpr int TL = NB * SEQ, TC = NB * CTXL, TT = TL + TC;
constexpr int KEYS = SEQ + CTXL;
constexpr int NIN = 11072, NINP = 11264;
constexpr int PC_KR = 256, PC_Q = 512, PC_CB = 1024, PC_CC = 3072, PC_CU = 5120, PC_GA = 7168, PC_GB = 9216;
constexpr int NEXP = 16384, PEER_H = 8, TOPK = 16;

constexpr size_t MiB = 1u << 20;
constexpr size_t WS_CTL = 0, CTL_ZERO_BYTES = 2 * MiB;
constexpr size_t WS_ADA = 2 * MiB;
constexpr size_t WS_ROPE = 3 * MiB;
constexpr size_t WS_CTXB = 4 * MiB;
constexpr size_t WS_IDX = 12 * MiB, WS_GW = 21 * MiB;
constexpr size_t WS_W = 30 * MiB, W_LAYER = 81 * MiB;
constexpr size_t WO_IN = 0, WO_Q = 44 * MiB, WO_KV = 47 * MiB, WO_A = 49 * MiB, WO_C = 57 * MiB, WO_O = 65 * MiB, WO_EFF = 73 * MiB;
constexpr size_t WS_UB = 192 * MiB, WS_VB = 256 * MiB;
constexpr size_t WS_P = 320 * MiB;
constexpr size_t WS_KA = 694 * MiB, WS_VA = 796 * MiB;
constexpr size_t WS_KN = 864 * MiB, WS_QR = 932 * MiB;
constexpr size_t WS_HB = 1034 * MiB;
constexpr size_t WS_END = 1102 * MiB;
static_assert(WS_P + (size_t)TT * NINP * 2 <= WS_KA && WS_KA + (size_t)NB * KEYS * 3072 * 2 <= WS_VA && WS_VA + (size_t)NB * KEYS * 2048 * 2 <= WS_KN && WS_KN + (size_t)TT * 2048 * 2 <= WS_QR && WS_QR + (size_t)TT * 3072 * 2 <= WS_HB && WS_HB + (size_t)TT * 2048 * 2 <= WS_END, "d_ws map");
static_assert(WS_W + 2 * W_LAYER <= WS_UB && WS_IDX + (size_t)TT * 128 * 4 <= WS_GW && WS_GW + (size_t)TT * 128 * 4 <= WS_W, "d_ws map 2");
constexpr int CW_BAR = 4096;
constexpr int CW_SSQ = 16384;
static_assert((CW_SSQ + 8 * TT) * 4 <= (int)CTL_ZERO_BYTES, "CTL words inside the memset region");

constexpr int RING_OFF = 0, RING_BYTES = 131072;
constexpr int LDSCTL_OFF = RING_BYTES, MISC_OFF = LDSCTL_OFF + 320;
constexpr int LDS_BYTES = 147456;
typedef unsigned short bf16;
typedef unsigned v4u __attribute__((ext_vector_type(4)));
typedef float f32x4 __attribute__((ext_vector_type(4)));
typedef __bf16 bf16x2_t __attribute__((ext_vector_type(2)));
#define LDS_WAIT() asm volatile("s_waitcnt lgkmcnt(0)" ::: "memory")
__device__ __forceinline__ unsigned f2bf(float f) { unsigned u = __builtin_bit_cast(unsigned, f); return (u + 0x7fffu + ((u >> 16) & 1u)) >> 16; }
__device__ __forceinline__ unsigned pk2(float lo, float hi) { return pg8::cvt_pk_bf16(lo, hi); }
__device__ __forceinline__ float blo(unsigned w) { return __uint_as_float(w << 16); }
__device__ __forceinline__ float bhi(unsigned w) { return __uint_as_float(w & 0xffff0000u); }
__device__ __forceinline__ float dot2bf(unsigned a, unsigned b, float c) { return __builtin_amdgcn_fdot2_f32_bf16(__builtin_bit_cast(bf16x2_t, a), __builtin_bit_cast(bf16x2_t, b), c, false); }
__device__ __forceinline__ float wave_sum(float v) {
#pragma unroll
    for (int o = 1; o < 64; o <<= 1) v += __shfl_xor(v, o);
    return v;
}

struct Frame {
    LAS unsigned char* lds;
    volatile LAS unsigned* MISC;
    unsigned* ctl;
    int tid, lane, wave;
    int vcu, G;
};
struct Args { const float* in[23]; float* out; unsigned char* ws; int ph_lo, ph_hi, li, pad; };

__device__ __forceinline__ void ada_item(Frame& F, const float* c, const float* cctx, const float* wmod, const float* bmod, float* ADA, int item) {
    const int l = item / 96, n0 = (item % 96) * 128;
    LAS float* sc = (LAS float*)(F.lds);
    LAS float* red = (LAS float*)(F.lds + 40960);
    for (int i = F.tid; i < 5 * 2048; i += 512) { const float v = (i < 4 * 2048) ? c[i] : cctx[i - 4 * 2048]; sc[i] = v / (1.0f + __expf(-v)); }
    __syncthreads();
    const float* wp = wmod + (size_t)l * 2048 * 12288 + n0 + 2 * F.lane;
    float a[5][2];
#pragma unroll
    for (int r = 0; r < 5; ++r) { a[r][0] = 0.f; a[r][1] = 0.f; }
    const int kb = F.wave * 256;
#pragma unroll 4
    for (int k = 0; k < 256; ++k) { const float2 w = *(const float2*)(wp + (size_t)(kb + k) * 12288);
#pragma unroll
        for (int r = 0; r < 5; ++r) { const float s = sc[r * 2048 + kb + k]; a[r][0] += s * w.x; a[r][1] += s * w.y; } }
#pragma unroll
    for (int r = 0; r < 5; ++r) { red[(F.wave * 5 + r) * 128 + 2 * F.lane] = a[r][0]; red[(F.wave * 5 + r) * 128 + 2 * F.lane + 1] = a[r][1]; }
    __syncthreads();
    for (int i = F.tid; i < 5 * 128; i += 512) { const int r = i >> 7, n = i & 127; float s = bmod[l * 12288 + n0 + n];
#pragma unroll
        for (int w = 0; w < 8; ++w) s += red[(w * 5 + r) * 128 + n];
        ADA[((size_t)l * 5 + r) * 12288 + n0 + n] = s; }
    __syncthreads();
}
__device__ __forceinline__ void transpose_item(const float* W, int ldw, int K, bf16* WT, int ndst, int nsrc, int k0, const float* gain, LAS float* scr, int lane) {
#pragma unroll 8
    for (int i = 0; i < 32; ++i) { const int kk = 2 * i + (lane >> 5); float v = 0.f; if (nsrc >= 0) { v = W[(size_t)(k0 + kk) * ldw + nsrc + (lane & 31)]; if (gain) v *= gain[k0 + kk]; } scr[kk * 33 + (lane & 31)] = v; }
    LDS_WAIT(); asm volatile("" ::: "memory");
    const int c = lane & 7;
#pragma unroll
    for (int j = 0; j < 4; ++j) { const int n = (lane >> 3) + 8 * j; const LAS float* s = scr + (8 * c) * 33 + n;
        v4u o; o.x = pk2(s[0 * 33], s[1 * 33]); o.y = pk2(s[2 * 33], s[3 * 33]); o.z = pk2(s[4 * 33], s[5 * 33]); o.w = pk2(s[6 * 33], s[7 * 33]);
        *(v4u*)(WT + (size_t)(ndst + n) * K + k0 + 8 * c) = o; }
    LDS_WAIT(); asm volatile("" ::: "memory");
}
__device__ __forceinline__ void weff_item(Frame& F, const float* wq, const float* sk, bf16* WeffT, int item) {
    const int hp = item >> 5, k0 = (item & 31) * 64;
    LAS float* s_sk = (LAS float*)(F.lds);
    LAS float* s_wq = (LAS float*)(F.lds + 128 * 132 * 4);
    for (int i = F.tid; i < 128 * 32; i += 512) { const int n = i >> 5, d4 = (i & 31) * 4; *(LAS f32x4*)(s_sk + n * 132 + d4) = *(const f32x4*)(sk + ((size_t)hp * 128 + n) * 128 + d4); }
    for (int i = F.tid; i < 64 * 32; i += 512) { const int k = i >> 5, d4 = (i & 31) * 4; *(LAS f32x4*)(s_wq + k * 132 + d4) = *(const f32x4*)(wq + (size_t)(k0 + k) * 2048 + hp * 128 + d4); }
    __syncthreads();
    const int n = F.tid & 127, kg = F.tid >> 7;
    float acc[16];
#pragma unroll
    for (int i = 0; i < 16; ++i) acc[i] = 0.f;
    for (int d4 = 0; d4 < 128; d4 += 4) { const f32x4 a = *(const LAS f32x4*)(s_sk + n * 132 + d4);
#pragma unroll
        for (int i = 0; i < 16; ++i) { const f32x4 b = *(const LAS f32x4*)(s_wq + (kg * 16 + i) * 132 + d4); acc[i] += (a[0] * b[0] + a[1] * b[1]) + (a[2] * b[2] + a[3] * b[3]); } }
    v4u o0, o1; o0.x = pk2(acc[0], acc[1]); o0.y = pk2(acc[2], acc[3]); o0.z = pk2(acc[4], acc[5]); o0.w = pk2(acc[6], acc[7]);
    o1.x = pk2(acc[8], acc[9]); o1.y = pk2(acc[10], acc[11]); o1.z = pk2(acc[12], acc[13]); o1.w = pk2(acc[14], acc[15]);
    bf16* dst = WeffT + (size_t)(hp * 128 + n) * 2048 + k0 + kg * 16; *(v4u*)dst = o0; *(v4u*)(dst + 8) = o1;
    __syncthreads();
}
template <class T> __device__ __forceinline__ T ldu6(const void* base, unsigned off) { return *(const T*)((const char*)base + off); }
__device__ __forceinline__ void norm_mod_row(const float* xrow, const float* gain, const float* shift, const float* scale, bf16* orow, int lane) {
    const unsigned l16 = (unsigned)lane * 16u; f32x4 v[8]; float s = 0.f;
#pragma unroll
    for (int j = 0; j < 8; ++j) { v[j] = ldu6<f32x4>(xrow, l16 + j * 1024); s += (v[j][0] * v[j][0] + v[j][1] * v[j][1]) + (v[j][2] * v[j][2] + v[j][3] * v[j][3]); }
    const float r = __builtin_amdgcn_rsqf(wave_sum(s) * (1.0f / 2048.0f) + pg8::RMS_EPS);
#pragma unroll
    for (int j = 0; j < 8; ++j) { const f32x4 g = ldu6<f32x4>(gain, l16 + j * 1024), sh = ldu6<f32x4>(shift, l16 + j * 1024), sc = ldu6<f32x4>(scale, l16 + j * 1024);
        const f32x4 y = (v[j] * r * g) * (sc + 1.0f) + sh;
        *(unsigned long long*)((char*)orow + (unsigned)lane * 8u + j * 512) = (unsigned long long)pk2(y[0], y[1]) | ((unsigned long long)pk2(y[2], y[3]) << 32); }
}
__device__ __forceinline__ int row_bi(int row) { return row < TL ? (row >> 12) : 4; }

template <int MODE> __device__ __forceinline__ void qk_norm_row(int row, const bf16* KN, const bf16* P, bf16* KA, bf16* QR, const float* gain, const float2* rope, int lane) {
    const int h = lane >> 2, j = lane & 3, e0 = 48 * j;
    v4u w[6];
#pragma unroll
    for (int c = 0; c < 6; ++c) { const int e = e0 + 8 * c;
        if (MODE == 1) w[c] = *(const v4u*)(QR + (size_t)row * 3072 + h * 192 + e);
        else w[c] = (e < 128) ? *(const v4u*)(KN + (size_t)row * 2048 + h * 128 + e) : *(const v4u*)(P + (size_t)row * NINP + PC_KR + (e - 128)); }
    float x[48]; float s = 0.f;
#pragma unroll
    for (int c = 0; c < 6; ++c) { x[8 * c + 0] = blo(w[c].x); x[8 * c + 1] = bhi(w[c].x); x[8 * c + 2] = blo(w[c].y); x[8 * c + 3] = bhi(w[c].y); x[8 * c + 4] = blo(w[c].z); x[8 * c + 5] = bhi(w[c].z); x[8 * c + 6] = blo(w[c].w); x[8 * c + 7] = bhi(w[c].w); }
#pragma unroll
    for (int i = 0; i < 48; ++i) s += x[i] * x[i];
    s += __shfl_xor(s, 1); s += __shfl_xor(s, 2);
    const float r = __builtin_amdgcn_rsqf(s * (1.0f / 192.0f) + pg8::RMS_EPS);
#pragma unroll
    for (int i = 0; i < 48; i += 4) { const f32x4 g = *(const f32x4*)(gain + e0 + i); x[i] *= r * g[0]; x[i + 1] *= r * g[1]; x[i + 2] *= r * g[2]; x[i + 3] *= r * g[3]; }
    if (row < TL) { const int pos = row & 4095;
#pragma unroll
        for (int i = 0; i < 48; i += 2) { const int e = e0 + i; if (e >= 128) { const float2 cs = rope[pos * 32 + ((e - 128) >> 1)]; const float a = x[i], b = x[i + 1]; x[i] = a * cs.x - b * cs.y; x[i + 1] = a * cs.y + b * cs.x; } } }
    bf16* dst = (MODE == 1) ? QR + (size_t)row * 3072 + h * 192 + e0 : KA + (size_t)pg8::key_row(row) * 3072 + h * 192 + e0;
#pragma unroll
    for (int c = 0; c < 6; ++c) { v4u o; o.x = pk2(x[8 * c], x[8 * c + 1]); o.y = pk2(x[8 * c + 2], x[8 * c + 3]); o.z = pk2(x[8 * c + 4], x[8 * c + 5]); o.w = pk2(x[8 * c + 6], x[8 * c + 7]); *(v4u*)(dst + 8 * c) = o; }
}
__device__ __forceinline__ void conv_item(const bf16* P, const float* cw, bf16* CV, int row, int ch) {
    const int pos = row < TL ? (row & 4095) : ((row - TL) & 255), len = row < TL ? SEQ : CTXL;
    const bf16* pr = P + (size_t)row * NINP + ch;
    float z[3][8];
#pragma unroll
    for (int j = 0; j < 3; ++j) { const int p = pos + j - 1; const bool ok = (p >= 0) && (p < len);
        if (ok) { const v4u c = *(const v4u*)(pr + (long)(j - 1) * NINP + PC_CC), u = *(const v4u*)(pr + (long)(j - 1) * NINP + PC_CU);
            z[j][0] = blo(c.x) * blo(u.x); z[j][1] = bhi(c.x) * bhi(u.x); z[j][2] = blo(c.y) * blo(u.y); z[j][3] = bhi(c.y) * bhi(u.y);
            z[j][4] = blo(c.z) * blo(u.z); z[j][5] = bhi(c.z) * bhi(u.z); z[j][6] = blo(c.w) * blo(u.w); z[j][7] = bhi(c.w) * bhi(u.w); }
        else {
#pragma unroll
            for (int i = 0; i < 8; ++i) z[j][i] = 0.f; } }
    const v4u b = *(const v4u*)(pr + PC_CB); const float bg[8] = {blo(b.x), bhi(b.x), blo(b.y), bhi(b.y), blo(b.z), bhi(b.z), blo(b.w), bhi(b.w)};
    float y[8];
#pragma unroll
    for (int i = 0; i < 8; ++i) y[i] = bg[i] * (cw[ch + i] * z[0][i] + cw[2048 + ch + i] * z[1][i] + cw[4096 + ch + i] * z[2][i]);
    v4u o; o.x = pk2(y[0], y[1]); o.y = pk2(y[2], y[3]); o.z = pk2(y[4], y[5]); o.w = pk2(y[6], y[7]);
    *(v4u*)(CV + (size_t)row * 2048 + ch) = o;
}

__device__ __forceinline__ int ord_key(float f) { int k = __float_as_int(f); return k ^ ((k >> 31) & 0x7fffffff); }
__device__ __forceinline__ float ord_val(int k) { return __int_as_float(k ^ ((k >> 31) & 0x7fffffff)); }
#define TOPK_INSERT(T, X) do { int x_ = (X); _Pragma("unroll") for (int i_ = 0; i_ < 16; ++i_) { const int hi_ = max(T[i_], x_); x_ = min(T[i_], x_); T[i_] = hi_; } } while (0)
__device__ __forceinline__ void topk_item(const float* SC, int* IDX, float* GW, int row0, LAS int* lists, int lane) {
#pragma unroll 1
    for (int pp = 0; pp < 2; ++pp) {
        const int L = pp * 64 + lane, tl = L >> 4, hp = L & 15;
        const f32x4* src = (const f32x4*)(SC + (size_t)(row0 + tl) * 2048 + hp * 128);
        int top[16];
#pragma unroll
        for (int i = 0; i < 16; ++i) top[i] = (int)0x80000000;
#pragma unroll 2
        for (int e4 = 0; e4 < 32; ++e4) { const f32x4 v = src[e4];
#pragma unroll
            for (int c = 0; c < 4; ++c) TOPK_INSERT(top, (ord_key(v[c]) & ~0x7F) | (e4 * 4 + c)); }
#pragma unroll
        for (int i = 0; i < 16; ++i) lists[i * 128 + L] = top[i];
    }
    LDS_WAIT(); asm volatile("" ::: "memory");
    const int tl = lane >> 3, h = lane & 7, LA = tl * 16 + 2 * h, LB = LA + 1;
    float va[16], vb[16];
#pragma unroll
    for (int i = 0; i < 16; ++i) { va[i] = ord_val(lists[i * 128 + LA] & ~0x7F); vb[i] = ord_val(lists[i * 128 + LB] & ~0x7F); }
    int best[16];
#pragma unroll
    for (int i = 0; i < 16; ++i) best[i] = (int)0x80000000;
#pragma unroll
    for (int i = 0; i < 16; ++i)
#pragma unroll
        for (int j = 0; j < 16; ++j) if ((i + 1) * (j + 1) <= 16) TOPK_INSERT(best, (ord_key(va[i] + vb[j]) & ~0xFF) | (i << 4) | j);
    float sc[16]; float ssum = 0.f; const float smax = ord_val(best[0] & ~0xFF);
    int ex[16];
#pragma unroll
    for (int k = 0; k < 16; ++k) { const int code = best[k] & 0xFF, i = code >> 4, j = code & 15;
        ex[k] = (lists[i * 128 + LA] & 0x7F) * 128 + (lists[j * 128 + LB] & 0x7F);
        sc[k] = __expf(ord_val(best[k] & ~0xFF) - smax); ssum += sc[k]; }
    const float inv = 1.0f / ssum;
    int* ip = IDX + (size_t)(row0 + tl) * 128 + h * 16; float* gp = GW + (size_t)(row0 + tl) * 128 + h * 16;
#pragma unroll
    for (int k = 0; k < 16; k += 4) { *(int4*)(ip + k) = make_int4(ex[k], ex[k + 1], ex[k + 2], ex[k + 3]); *(f32x4*)(gp + k) = (f32x4){sc[k] * inv, sc[k + 1] * inv, sc[k + 2] * inv, sc[k + 3] * inv}; }
    LDS_WAIT(); asm volatile("" ::: "memory");
}

template <class T> __device__ __forceinline__ T ldu(const void* base, unsigned off) { return *(const T*)((const char*)base + off); }
template <class T> __device__ __forceinline__ void stu(void* base, unsigned off, T v) { *(T*)((char*)base + off) = v; }
__device__ __forceinline__ void peer_row(const bf16* hrow, const int* idx, const float* gw, const bf16* UB, const bf16* VB, float (&out)[32], int lane) {
    const unsigned l16 = (unsigned)lane * 16u;
    v4u hv[4];
#pragma unroll
    for (int j = 0; j < 4; ++j) hv[j] = ldu<v4u>(hrow, l16 + j * 1024);
#pragma unroll
    for (int i = 0; i < 32; ++i) out[i] = 0.f;
    const int mybt = (lane >> 2) & 3; const bool b5 = lane & 32, b4 = lane & 16;
    const unsigned myk4 = (unsigned)(mybt * 4 + ((lane >> 5) & 1) * 2 + ((lane >> 4) & 1)) * 4u;
#pragma unroll 1
    for (int hd = 0; hd < 8; ++hd) {
        const int my_e = ldu<int>(idx + hd * 16, myk4); const float my_g = ldu<float>(gw + hd * 16, myk4);
        float tot = 0.f;
#pragma unroll 1
        for (int bt = 0; bt < 4; ++bt) {
            v4u w[4][4];
#pragma unroll
            for (int e = 0; e < 4; ++e) { const int ei = __builtin_amdgcn_readlane(my_e, bt * 4 + (e >> 1) * 32 + (e & 1) * 16); const bf16* up = UB + (size_t)ei * 2048;
#pragma unroll
                for (int j = 0; j < 4; ++j) w[e][j] = ldu<v4u>(up, l16 + j * 1024); }
            float d[4];
#pragma unroll
            for (int e = 0; e < 4; ++e) { float a0 = 0.f, a1 = 0.f;
#pragma unroll
                for (int j = 0; j < 4; ++j) { a0 = dot2bf(w[e][j].x, hv[j].x, a0); a1 = dot2bf(w[e][j].y, hv[j].y, a1); a0 = dot2bf(w[e][j].z, hv[j].z, a0); a1 = dot2bf(w[e][j].w, hv[j].w, a1); }
                d[e] = a0 + a1; }
            float t2[2], t1;
#pragma unroll
            for (int i = 0; i < 2; ++i) { const float mine = b5 ? d[2 + i] : d[i], send = b5 ? d[i] : d[2 + i]; t2[i] = mine + __shfl_xor(send, 32); }
            { const float mine = b4 ? t2[1] : t2[0], send = b4 ? t2[0] : t2[1]; t1 = mine + __shfl_xor(send, 16); }
            t1 += __shfl_xor(t1, 8); t1 += __shfl_xor(t1, 4); t1 += __shfl_xor(t1, 2); t1 += __shfl_xor(t1, 1);
            tot = (bt == mybt) ? t1 : tot;
        }
        const float wgt = my_g * 0.5f * tot * (1.0f + erff(tot * 0.70710678118654752f));
#pragma unroll 1
        for (int bt = 0; bt < 4; ++bt) {
            v4u w[4][4];
#pragma unroll
            for (int e = 0; e < 4; ++e) { const int ei = __builtin_amdgcn_readlane(my_e, bt * 4 + (e >> 1) * 32 + (e & 1) * 16); const bf16* vp = VB + (size_t)ei * 2048;
#pragma unroll
                for (int j = 0; j < 4; ++j) w[e][j] = ldu<v4u>(vp, l16 + j * 1024); }
#pragma unroll
            for (int e = 0; e < 4; ++e) { const float we = __int_as_float(__builtin_amdgcn_readlane(__float_as_int(wgt), bt * 4 + (e >> 1) * 32 + (e & 1) * 16));
#pragma unroll
                for (int j = 0; j < 4; ++j) { const v4u q = w[e][j];
                    out[8 * j + 0] += we * blo(q.x); out[8 * j + 1] += we * bhi(q.x); out[8 * j + 2] += we * blo(q.y); out[8 * j + 3] += we * bhi(q.y);
                    out[8 * j + 4] += we * blo(q.z); out[8 * j + 5] += we * bhi(q.z); out[8 * j + 6] += we * blo(q.w); out[8 * j + 7] += we * bhi(q.w); } }
        }
    }
}

#if defined(__HIP_DEVICE_COMPILE__)
#define ASSUME_GLOBAL(p) do { __builtin_assume(!__builtin_amdgcn_is_shared((const __attribute__((address_space(0))) void*)(p))); __builtin_assume(!__builtin_amdgcn_is_private((const __attribute__((address_space(0))) void*)(p))); } while (0)
#else
#define ASSUME_GLOBAL(p) do { } while (0)
#endif
__device__ __forceinline__ const float* inp_ptr(const Args& a, int k) { asm volatile("" : "+s"(k)); const float* p = a.in[k]; ASSUME_GLOBAL(p); return p; }
constexpr int NPHASE = 22;
__global__ void __launch_bounds__(NWAVES * 64, 2) fwd_kernel(Args args) {
    extern __shared__ __attribute__((aligned(16))) unsigned char lds[];
    Frame F;
    F.lds = (LAS unsigned char*)lds;
    F.MISC = (volatile LAS unsigned*)(F.lds + MISC_OFF);
    F.tid = threadIdx.x; F.lane = F.tid & 63; F.wave = __builtin_amdgcn_readfirstlane(F.tid >> 6);
    F.G = gridDim.x; { const int bx = blockIdx.x; F.vcu = (F.G % 8 == 0) ? (bx % 8) * (F.G / 8) + bx / 8 : bx; }
    F.ctl = (unsigned*)(args.ws + WS_CTL);
    for (int u = F.tid; u < (LDS_BYTES - LDSCTL_OFF) / 4; u += NWAVES * 64) ((LAS unsigned*)(F.lds + LDSCTL_OFF))[u] = 0u;
    __syncthreads();
    XcdBarrier bar = xcd_barrier_post((unsigned*)(F.ctl + CW_BAR), F.MISC + 8);
    const int lo = args.ph_lo, hi = args.ph_hi;
#define IN(k) (lo <= (k) && (k) < hi)
#ifndef PHMASK
#define PHMASK 0xFFF
#endif
#define EN(b) ((PHMASK >> (b)) & 1)
#define PHASE_BEGIN() int ptid_ = threadIdx.x; asm volatile("" : "+v"(ptid_)); Frame Fp = F; Fp.tid = ptid_; Fp.lane = ptid_ & 63; const int gt = bid * 512 + Fp.tid; (void)gt; \
    size_t oz_ = 0; asm volatile("" : "+s"(oz_)); unsigned char* ws = args.ws + oz_; float* xout = args.out + oz_; (void)xout
#define INP(k_) (args.in[k_] + oz_)
#define WSP(T_, off_) ((T_*)(ws + (off_)))
#define SEAM(k) do { if (IN(k) && IN((k) + 1)) xcd_barrier(bar); } while (0)
    const int gw = F.vcu * NWAVES + F.wave, NGW = F.G * NWAVES, bid = F.vcu;
    const int NGT = F.G * 512;

    if (EN(0) && IN(0)) { PHASE_BEGIN();
        const float* c_in = INP(1); const float* cctx_in = INP(3); const float* w_mod = INP(4); const float* b_mod = INP(5); const float* w_in = INP(7);
        const float* q_a_norm = INP(8); const float* kv_a_norm = INP(9); const float* w_q_up = INP(10); const float* w_kv_up = INP(11);
        const float* w_attn_out = INP(15); const float* w_conv_out = INP(16); const float* w_o = INP(17); const float* w_query = INP(19); const float* sub_keys = INP(20);
        float* ADA = WSP(float, WS_ADA); float2* ROPE = WSP(float2, WS_ROPE);
        for (int it = bid; it < 192; it += F.G) ada_item(Fp, c_in, cctx_in, w_mod, b_mod, ADA, it);
        {   LAS float* scr = (LAS float*)(F.lds + RING_OFF + F.wave * 16384);
            constexpr int I_IN = 32 * 352, I_Q = 8 * 96, I_KV = 4 * 128, I_SQ = 32 * 64, I_L = I_IN + I_Q + I_KV + 3 * I_SQ;
            for (int it = gw; it < 2 * I_L; it += NGW) {
                const int l = it / I_L; int r = it % I_L; bf16* wl = (bf16*)(ws + WS_W + (size_t)l * W_LAYER);
                if (r < I_IN) { const int kb = r / 352, n0 = (r % 352) * 32; const int ns = n0 < 320 ? n0 : (n0 < 512 ? -1 : n0 - 192);
                    transpose_item(w_in + (size_t)l * 2048 * NIN, NIN, 2048, (bf16*)((char*)wl + WO_IN), n0, ns, kb * 64, nullptr, scr, Fp.lane); continue; } r -= I_IN;
                if (r < I_Q) { const int kb = r / 96, n0 = (r % 96) * 32;
                    transpose_item(w_q_up + (size_t)l * 512 * 3072, 3072, 512, (bf16*)((char*)wl + WO_Q), n0, n0, kb * 64, q_a_norm + l * 512, scr, Fp.lane); continue; } r -= I_Q;
                if (r < I_KV) { const int kb = r / 128, n0 = (r % 128) * 32; const int ns = n0 < 2048 ? (n0 >> 7) * 256 + (n0 & 127) : ((n0 - 2048) >> 7) * 256 + 128 + ((n0 - 2048) & 127);
                    transpose_item(w_kv_up + (size_t)l * 256 * 4096, 4096, 256, (bf16*)((char*)wl + WO_KV), n0, ns, kb * 64, kv_a_norm + l * 256, scr, Fp.lane); continue; } r -= I_KV;
                const int m = r / I_SQ; r %= I_SQ; const int kb = r / 64, n0 = (r % 64) * 32;
                const float* src = (m == 0 ? w_attn_out : (m == 1 ? w_conv_out : w_o)) + (size_t)l * 2048 * 2048;
                transpose_item(src, 2048, 2048, (bf16*)((char*)wl + (m == 0 ? WO_A : (m == 1 ? WO_C : WO_O))), n0, n0, kb * 64, nullptr, scr, Fp.lane);
            }
        }
        __syncthreads();
        for (int it = bid; it < 2 * 512; it += F.G) { const int l = it >> 9;
            weff_item(Fp, w_query + (size_t)l * 2048 * 2048, sub_keys + (size_t)l * 16 * 128 * 128, (bf16*)(ws + WS_W + (size_t)l * W_LAYER + WO_EFF), it & 511); }
        for (int i = gt; i < 4096 * 32; i += NGT) { const int pos = i >> 5, p = i & 31; const float fpos = (float)(p < 16 ? (pos >> 6) : (pos & 63));
            const float invf = exp2f(-(float)(p & 15) * (13.287712379549449f / 16.0f)); const float ang = fpos * invf;
            float rev = ang * 0.15915494309189535f; rev -= rintf(rev); ROPE[i] = make_float2(__builtin_amdgcn_cosf(rev), __builtin_amdgcn_sinf(rev)); }
    }
    SEAM(0);
    if (EN(1) && IN(1)) { PHASE_BEGIN();
        const float* x_in = INP(0); const float* ctx_in = INP(2); const float* ln_mix = INP(6); const float* ADA = WSP(float, WS_ADA); bf16* HB = WSP(bf16, WS_HB);
        for (int row_ = gw; row_ < TT; row_ += NGW) { int row = row_; asm volatile("" : "+s"(row)); const int bi = row_bi(row); const float* ap = ADA + (size_t)bi * 12288;
            norm_mod_row(row < TL ? x_in + (size_t)row * DM : ctx_in + (size_t)(row - TL) * DM, ln_mix, ap, ap + 2048, HB + (size_t)row * DM, Fp.lane); }
    }
    SEAM(1);
#pragma unroll 1
    for (int l = 0; l < NLAYER; ++l) {
        const int pb = 2 + 10 * l;
        const int MR = (l == 0) ? TT : TL;
#define LAYER_W() bf16* wl = WSP(bf16, WS_W + (size_t)l * W_LAYER); (void)wl
#define LAYER_SSQ() unsigned long long* ssq_kv = (unsigned long long*)((unsigned*)(ws + WS_CTL) + CW_SSQ) + (size_t)(2 * l) * TT; unsigned long long* ssq_q = ssq_kv + TT; (void)ssq_q
#define LAYER_ADA() const float* ada_l = WSP(float, WS_ADA) + (size_t)l * 5 * 12288
        if (EN(2) && IN(pb + 0)) { PHASE_BEGIN();
            LAYER_W(); LAYER_SSQ(); const bf16* Win_t = (const bf16*)((char*)wl + WO_IN); bf16* HB = WSP(bf16, WS_HB); bf16* P = WSP(bf16, WS_P);
            { pg8::Gemm g{HB, Win_t, MR, NINP, 2048, 2048, 2048}; pg8::StaticOrder S; S.init(MR, NINP, F.G, (int)blockIdx.x);
              pg8::EpiP E{P, NINP, ssq_kv, ssq_q};
              pg8::gemm_phase<pg8::EpiP, pg8::StaticOrder, true, true>(F.lds + RING_OFF, g, S, E); }
            { const int Mc = TT - MR; pg8::Gemm g{HB + (size_t)TL * DM, Win_t, Mc, 512, 2048, 2048, 2048}; pg8::StaticOrder S; S.init(Mc, 512, F.G, (int)blockIdx.x);
              pg8::EpiP E{P + (size_t)TL * NINP, NINP, ssq_kv + TL, ssq_q + TL};
              pg8::gemm_phase<pg8::EpiP, pg8::StaticOrder, true, true>(F.lds + RING_OFF, g, S, E); }
        }
        SEAM(pb + 0);
        if (EN(3) && IN(pb + 1)) { PHASE_BEGIN();
            LAYER_W(); LAYER_SSQ(); const bf16* Wq_t = (const bf16*)((char*)wl + WO_Q); const bf16* Wkv_t = (const bf16*)((char*)wl + WO_KV);
            bf16* P = WSP(bf16, WS_P); bf16* KN = WSP(bf16, WS_KN); bf16* VA = WSP(bf16, WS_VA); bf16* QR = WSP(bf16, WS_QR);
            { pg8::Gemm g{P, Wkv_t, TT, 4096, 256, NINP, 256}; pg8::StaticOrder S; S.init(TT, 4096, F.G, (int)blockIdx.x);
              pg8::EpiKV E{KN, VA, ssq_kv, 0};
              pg8::gemm_phase<pg8::EpiKV, pg8::StaticOrder, true, true>(F.lds + RING_OFF, g, S, E); }
            { pg8::Gemm g{P + PC_Q, Wq_t, MR, 3072, 512, NINP, 512}; pg8::StaticOrder S; S.init(MR, 3072, F.G, (int)blockIdx.x);
              pg8::EpiQ E{QR, ssq_q};
              pg8::gemm_phase<pg8::EpiQ, pg8::StaticOrder, true, true>(F.lds + RING_OFF, g, S, E); }
        }
        SEAM(pb + 1);
        if (EN(4) && IN(pb + 2)) { PHASE_BEGIN();
            const float* q_norm = INP(12); const float* k_norm = INP(13); const float* conv_w = INP(14); const float2* ROPE = WSP(float2, WS_ROPE);
            bf16* P = WSP(bf16, WS_P); bf16* KN = WSP(bf16, WS_KN); bf16* KA = WSP(bf16, WS_KA); bf16* QR = WSP(bf16, WS_QR); bf16* CV = WSP(bf16, WS_HB);
            for (int row_ = gw; row_ < TT; row_ += NGW) { int row = row_; asm volatile("" : "+s"(row)); qk_norm_row<0>(row, KN, P, KA, QR, k_norm + l * 192, ROPE, Fp.lane); }
            for (int row_ = gw; row_ < MR; row_ += NGW) { int row = row_; asm volatile("" : "+s"(row)); qk_norm_row<1>(row, KN, P, KA, QR, q_norm + l * 192, ROPE, Fp.lane); }
            for (int i = gt; i < MR * 256; i += NGT) conv_item(P, conv_w + (size_t)l * 3 * 2048, CV, i >> 8, (i & 255) * 8);
        }
        SEAM(pb + 2);
        if (EN(5) && IN(pb + 3)) { PHASE_BEGIN();
            const bf16* KA = WSP(bf16, WS_KA); const bf16* VA = WSP(bf16, WS_VA); const bf16* QR = WSP(bf16, WS_QR); bf16* ATT = WSP(bf16, WS_KN);
            const int NU = 1024 + ((l == 0) ? 64 : 0);
            for (int i = 0;; ++i) { const int u = i * F.G + F.vcu; if (u >= NU) break;
                if (u < 1024) { const int b = u >> 8, h = (u >> 4) & 15, qb = u & 15;
                    att::attn_unit(QR + (size_t)(b * SEQ + qb * 256) * 3072 + h * 192, KA + (size_t)(b * KEYS) * 3072 + h * 192, VA + (size_t)(b * KEYS) * 2048 + h * 128,
                                   ATT + (size_t)(b * SEQ + qb * 256) * 2048 + h * 128, KEYS, (char*)lds + RING_OFF); }
                else { const int uc = u - 1024, b = uc >> 4, h = uc & 15;
                    att::attn_unit(QR + (size_t)(TL + b * CTXL) * 3072 + h * 192, KA + (size_t)(b * KEYS + SEQ) * 3072 + h * 192, VA + (size_t)(b * KEYS + SEQ) * 2048 + h * 128,
                                   ATT + (size_t)(TL + b * CTXL) * 2048 + h * 128, CTXL, (char*)lds + RING_OFF); } }
        }
        SEAM(pb + 3);
        if (EN(6) && IN(pb + 4)) { PHASE_BEGIN();
            LAYER_W(); const bf16* Wa_t = (const bf16*)((char*)wl + WO_A); const bf16* Wc_t = (const bf16*)((char*)wl + WO_C);
            const bf16* P = WSP(bf16, WS_P); const bf16* ATT = WSP(bf16, WS_KN); const bf16* CV = WSP(bf16, WS_HB); bf16* Y1 = WSP(bf16, WS_KA); bf16* MB = WSP(bf16, WS_VA);
            { pg8::Gemm g{ATT, Wa_t, MR, 2048, 2048, 2048, 2048}; pg8::StaticOrder S; S.init(MR, 2048, F.G, (int)blockIdx.x);
              pg8::EpiGate<false> E{Y1, nullptr, P + PC_GA, NINP};
              pg8::gemm_phase<pg8::EpiGate<false>, pg8::StaticOrder, true, true>(F.lds + RING_OFF, g, S, E); }
            { pg8::Gemm g{CV, Wc_t, MR, 2048, 2048, 2048, 2048}; pg8::StaticOrder S; S.init(MR, 2048, F.G, (int)blockIdx.x);
              pg8::EpiGate<true> E{MB, Y1, P + PC_GB, NINP};
              pg8::gemm_phase<pg8::EpiGate<true>, pg8::StaticOrder, true, true>(F.lds + RING_OFF, g, S, E); }
        }
        SEAM(pb + 4);
        if (EN(7) && IN(pb + 5)) { PHASE_BEGIN();
            LAYER_W(); LAYER_ADA(); const bf16* Wo_t = (const bf16*)((char*)wl + WO_O); const bf16* MB = WSP(bf16, WS_VA); float* CTXB = WSP(float, WS_CTXB);
            const float* x_in = INP(0); const float* ctx_in = INP(2);
            pg8::Gemm g{MB, Wo_t, MR, 2048, 2048, 2048, 2048}; pg8::StaticOrder S; S.init(MR, 2048, F.G, (int)blockIdx.x);
            pg8::EpiRes E{l == 0 ? x_in : xout, xout, ada_l, ctx_in, CTXB};
            pg8::gemm_phase<pg8::EpiRes, pg8::StaticOrder, true, true>(F.lds + RING_OFF, g, S, E);
        }
        SEAM(pb + 5);
        if (EN(8) && IN(pb + 6)) { PHASE_BEGIN();
            LAYER_ADA(); const float* ln_ffn = INP(18); const float* u_exp = INP(21); const float* v_exp = INP(22); float* CTXB = WSP(float, WS_CTXB); bf16* HB = WSP(bf16, WS_HB);
            bf16* UB = WSP(bf16, WS_UB); bf16* VB = WSP(bf16, WS_VB);
            for (int row_ = gw; row_ < MR; row_ += NGW) { int row = row_; asm volatile("" : "+s"(row)); const int bi = row_bi(row); const float* ap = ada_l + (size_t)bi * 12288;
                norm_mod_row(row < TL ? xout + (size_t)row * DM : CTXB + (size_t)(row - TL) * DM, ln_ffn + l * DM, ap + 3 * 2048, ap + 4 * 2048, HB + (size_t)row * DM, Fp.lane); }
            const float* us = u_exp + (size_t)l * NEXP * DM; const float* vs = v_exp + (size_t)l * NEXP * DM;
            for (int i = gt; i < 2 * (NEXP * DM / 8); i += NGT) { const bool isv = i >= NEXP * DM / 8; const size_t e = (size_t)(isv ? i - NEXP * DM / 8 : i) * 8;
                const f32x4 a = *(const f32x4*)((isv ? vs : us) + e), b = *(const f32x4*)((isv ? vs : us) + e + 4);
                v4u o; o.x = pk2(a[0], a[1]); o.y = pk2(a[2], a[3]); o.z = pk2(b[0], b[1]); o.w = pk2(b[2], b[3]); *(v4u*)((isv ? VB : UB) + e) = o; }
        }
        SEAM(pb + 6);
        if (EN(9) && IN(pb + 7)) { PHASE_BEGIN();
            LAYER_W(); const bf16* Weff_t = (const bf16*)((char*)wl + WO_EFF); const bf16* HB = WSP(bf16, WS_HB); float* SC = WSP(float, WS_P);
            pg8::Gemm g{HB, Weff_t, MR, 2048, 2048, 2048, 2048}; pg8::StaticOrder S; S.init(MR, 2048, F.G, (int)blockIdx.x);
            pg8::EpiF32 E{SC, 2048};
            pg8::gemm_phase<pg8::EpiF32, pg8::StaticOrder, true, true>(F.lds + RING_OFF, g, S, E);
        }
        SEAM(pb + 7);
        if (EN(10) && IN(pb + 8)) { PHASE_BEGIN();
            const float* SC = WSP(float, WS_P); int* IDX = WSP(int, WS_IDX); float* GW = WSP(float, WS_GW);
            LAS int* lists = (LAS int*)(F.lds + RING_OFF + F.wave * 8192);
            for (int it_ = gw; it_ < MR / 8; it_ += NGW) { int it = it_; asm volatile("" : "+s"(it)); topk_item(SC, IDX, GW, it * 8, lists, Fp.lane); }
        }
        SEAM(pb + 8);
        if (EN(11) && IN(pb + 9)) { PHASE_BEGIN();
            LAYER_ADA(); const float* ln_mix = INP(6); const float* ADA = WSP(float, WS_ADA); float* CTXB = WSP(float, WS_CTXB); bf16* HB = WSP(bf16, WS_HB);
            const int* IDX = WSP(int, WS_IDX); const float* GW = WSP(float, WS_GW); const bf16* UB = WSP(bf16, WS_UB); const bf16* VB = WSP(bf16, WS_VB);
            for (int row_ = gw; row_ < MR; row_ += NGW) { int row = row_; asm volatile("" : "+s"(row));
                float o[32];
                peer_row(HB + (size_t)row * DM, IDX + (size_t)row * 128, GW + (size_t)row * 128, UB, VB, o, Fp.lane);
                const int bi = row_bi(row); const float* g2 = ada_l + (size_t)bi * 12288 + 5 * 2048;
                float* xr = (row < TL) ? xout + (size_t)row * DM : CTXB + (size_t)(row - TL) * DM;
                float s = 0.f; const unsigned l32 = (unsigned)Fp.lane * 32u, l16 = (unsigned)Fp.lane * 16u;
#pragma unroll
                for (int j = 0; j < 4; ++j) {
                    const f32x4 a = ldu<f32x4>(xr, l32 + j * 2048), b = ldu<f32x4>(xr, l32 + j * 2048 + 16), ga = ldu<f32x4>(g2, l32 + j * 2048), gb = ldu<f32x4>(g2, l32 + j * 2048 + 16);
                    f32x4 na, nb;
#pragma unroll
                    for (int c = 0; c < 4; ++c) { na[c] = a[c] + ga[c] * o[8 * j + c]; nb[c] = b[c] + gb[c] * o[8 * j + 4 + c]; o[8 * j + c] = na[c]; o[8 * j + 4 + c] = nb[c]; s += na[c] * na[c] + nb[c] * nb[c]; }
                    stu<f32x4>(xr, l32 + j * 2048, na); stu<f32x4>(xr, l32 + j * 2048 + 16, nb); }
                if (l + 1 < NLAYER) {
                    const float r = __builtin_amdgcn_rsqf(wave_sum(s) * (1.0f / 2048.0f) + pg8::RMS_EPS);
                    const float* gain = ln_mix + (l + 1) * DM; const float* ap = ADA + ((size_t)(l + 1) * 5 + bi) * 12288;
#pragma unroll
                    for (int j = 0; j < 4; ++j) {
                        const f32x4 g0 = ldu<f32x4>(gain, l32 + j * 2048), g1 = ldu<f32x4>(gain, l32 + j * 2048 + 16), s0 = ldu<f32x4>(ap + 2048, l32 + j * 2048), s1 = ldu<f32x4>(ap + 2048, l32 + j * 2048 + 16),
                                    h0 = ldu<f32x4>(ap, l32 + j * 2048), h1 = ldu<f32x4>(ap, l32 + j * 2048 + 16);
                        float y[8];
#pragma unroll
                        for (int c = 0; c < 4; ++c) { y[c] = (o[8 * j + c] * r * g0[c]) * (s0[c] + 1.0f) + h0[c]; y[4 + c] = (o[8 * j + 4 + c] * r * g1[c]) * (s1[c] + 1.0f) + h1[c]; }
                        v4u w; w.x = pk2(y[0], y[1]); w.y = pk2(y[2], y[3]); w.z = pk2(y[4], y[5]); w.w = pk2(y[6], y[7]); stu<v4u>(HB + (size_t)row * DM, l16 + j * 1024, w); }
                }
            }
        }
        SEAM(pb + 9);
    }
#undef IN
#undef SEAM
}

#ifndef MK_N_LAUNCHES
#define MK_N_LAUNCHES 22
#endif
extern "C" void kernel_launch(void* const* d_in, const int* in_sizes, int n_in, void* d_out, int out_size, void* d_ws, size_t ws_size, hipStream_t stream) {
    static int grid = 0;
    if (grid == 0) {
        if (n_in != 23 || out_size != TL * DM || ws_size < WS_END) { fprintf(stderr, "kernel_launch: shape/workspace mismatch (n_in %d out %d ws %zu need %zu)\n", n_in, out_size, ws_size, (size_t)WS_END); grid = -1; return; }
        int dev = 0, cus = 0;
        if (hipGetDevice(&dev) != hipSuccess || hipDeviceGetAttribute(&cus, hipDeviceAttributeMultiprocessorCount, dev) != hipSuccess) { grid = -1; return; }
        if (hipFuncSetAttribute((const void*)fwd_kernel, hipFuncAttributeMaxDynamicSharedMemorySize, LDS_BYTES) != hipSuccess) { fprintf(stderr, "kernel_launch: hipFuncSetAttribute failed\n"); grid = -1; return; }
        int per_cu = 0;
        if (hipOccupancyMaxActiveBlocksPerMultiprocessor(&per_cu, (const void*)fwd_kernel, NWAVES * 64, LDS_BYTES) != hipSuccess || per_cu < 1) { fprintf(stderr, "kernel_launch: occupancy query reports %d\n", per_cu); (void)hipGetLastError(); }
        grid = cus;
    }
    if (grid < 0) return;
    if (hipMemsetAsync((char*)d_ws + WS_CTL, 0, CTL_ZERO_BYTES, stream) != hipSuccess) return;
    Args a{};
    for (int i = 0; i < 23; ++i) a.in[i] = (const float*)d_in[i];
    a.out = (float*)d_out; a.ws = (unsigned char*)d_ws;
#if MK_N_LAUNCHES == 1
    a.ph_lo = 0; a.ph_hi = NPHASE; a.li = 0;
    hipLaunchKernelGGL(fwd_kernel, dim3(grid), dim3(NWAVES * 64), LDS_BYTES, stream, a);
#else
    for (int p = 0; p < NPHASE; ++p) { a.ph_lo = p; a.ph_hi = p + 1; a.li = p; hipLaunchKernelGGL(fwd_kernel, dim3(grid), dim3(NWAVES * 64), LDS_BYTES, stream, a); }
#endif
}
```

```cpp
#include <hip/hip_runtime.h>
#include <cstdio>
#include <cstdint>
namespace pg8 {
#define PG8_LAS __attribute__((address_space(3)))
typedef unsigned short bf16_t;
typedef short bf16x8 __attribute__((ext_vector_type(8)));
typedef float f32x4 __attribute__((ext_vector_type(4)));
typedef unsigned u32x4 __attribute__((ext_vector_type(4)));
constexpr int BM = 256, BK = 64, HALF = 128, HTB = HALF * BK * 2  , STAGE_BYTES = 8 * HTB, NXCD = 8, WGM = 8;

__host__ __device__ __forceinline__ int lds_byte(int r, int c) { const int st = (r >> 4) * 2 + (c >> 5), rr = r & 15, cc = c & 31, ob = rr * 64 + cc * 2; return st * 1024 + (ob ^ (((ob >> 9) & 1) << 5)); }
__host__ __device__ __forceinline__ void stage_rc(int b, int& R, int& C) { const int st = b / 1024, sb = b % 1024, swz = sb ^ (((sb >> 9) & 1) << 5); R = (st >> 1) * 16 + swz / 64; C = (st & 1) * 32 + (swz % 64) / 2; }
__host__ __device__ __forceinline__ int perm32(int rho) { const int n = rho >> 4, i = rho & 15; return 8 * (i >> 2) + 4 * n + (i & 3); }

struct Unit { int pm, pn; };
struct Gemm { const bf16_t* A; const bf16_t* Bt; int M, N, K, lda, ldb; };

struct StaticOrder {
    int nM, nN, nwg, G, c;
    __host__ __device__ void init(int M, int N, int G_, int c_) { nM = M / BM; nN = N / BM; nwg = nM * nN; G = G_; c = c_; }
    __host__ __device__ bool next(int i, Unit& u) const {
        const long L = (long)i * G + c; if (L >= nwg) return false;
        int wgid = (int)L; { const int q = nwg / NXCD, r = nwg % NXCD, xcd = wgid % NXCD, off = wgid / NXCD; wgid = (xcd < r ? xcd * (q + 1) : r * (q + 1) + (xcd - r) * q) + off; }
        const int nig = WGM * nN, gid = wgid / nig, fm = gid * WGM, gsz = (nM - fm) < WGM ? (nM - fm) : WGM;
        u.pm = fm + ((wgid % nig) % gsz); u.pn = (wgid % nig) / gsz; return true;
    }
    __device__ __forceinline__ void a_ready(const Unit&) const {}
    __device__ __forceinline__ void done(const Unit&) const {}
};

__device__ __forceinline__ unsigned cvt_pk_bf16(float lo, float hi) { unsigned r; asm volatile("v_cvt_pk_bf16_f32 %0, %1, %2" : "=v"(r) : "v"(lo), "v"(hi)); return r; }
__device__ __forceinline__ float bf_lo(unsigned w) { return __uint_as_float(w << 16); }
__device__ __forceinline__ float bf_hi(unsigned w) { return __uint_as_float(w & 0xffff0000u); }
__device__ __forceinline__ float sigmoidf_(float x) { return __builtin_amdgcn_rcpf(1.0f + __expf(-x)); }
__device__ __forceinline__ u32x4 pack8(const f32x4 v0, const f32x4 v1) { u32x4 w; w.x = cvt_pk_bf16(v0[0], v0[1]); w.y = cvt_pk_bf16(v0[2], v0[3]); w.z = cvt_pk_bf16(v1[0], v1[1]); w.w = cvt_pk_bf16(v1[2], v1[3]); return w; }
constexpr float RMS_EPS = 1e-6f;

struct EpiP {
    static constexpr bool PERM = true, AFTER_DRAIN = false;
    bf16_t* O; int ldc; unsigned long long* ssq_kv; unsigned long long* ssq_q;
    __device__ __forceinline__ void operator()(const f32x4 (&acc)[2][2][4][2], const Unit& u, int wr, int wc, int fr, int fq) const {
        const int row0 = u.pm * BM + wr * 64 + fr, col0 = u.pn * BM + wc * 32 + 8 * fq;
        unsigned long long* ssq = (u.pn == 0) ? ssq_kv : ((u.pn == 2 || u.pn == 3) ? ssq_q : nullptr);
#pragma unroll
        for (int ai = 0; ai < 2; ++ai)
#pragma unroll
            for (int m = 0; m < 4; ++m) { const int row = row0 + ai * HALF + m * 16; bf16_t* rowp = O + (size_t)row * ldc + col0; float s = 0.f;
#pragma unroll
                for (int bj = 0; bj < 2; ++bj) { const f32x4 v0 = acc[ai][bj][m][0], v1 = acc[ai][bj][m][1];
                    s += (v0[0] * v0[0] + v0[1] * v0[1]) + (v0[2] * v0[2] + v0[3] * v0[3]) + (v1[0] * v1[0] + v1[1] * v1[1]) + (v1[2] * v1[2] + v1[3] * v1[3]);
                    *(u32x4*)(rowp + bj * HALF) = pack8(v0, v1); }
                if (ssq) { s += __shfl_xor(s, 16); s += __shfl_xor(s, 32); if (fq == 0) atomicAdd(ssq + row, (unsigned long long)(s * 1048576.0f)); } }
    }
};
__device__ __forceinline__ int key_row(int row) { return row < 16384 ? (row >> 12) * 4352 + (row & 4095) : ((row - 16384) >> 8) * 4352 + 4096 + ((row - 16384) & 255); }
struct EpiKV {
    static constexpr bool PERM = true, AFTER_DRAIN = false;
    bf16_t* KN; bf16_t* VA; const unsigned long long* ssq; int row_off;
    __device__ __forceinline__ void operator()(const f32x4 (&acc)[2][2][4][2], const Unit& u, int wr, int wc, int fr, int fq) const {
        const bool isv = u.pn >= 8;
        const int delta = u.pm < 64 ? (u.pm >> 4) * 256 : (u.pm - 64) * 4096 - 12288;
        char* base = isv ? (char*)(VA + (size_t)delta * 2048) : (char*)KN;
        const int rl = wr * 64 + fr;
        const unsigned off0 = ((unsigned)(u.pm * BM + rl) * 2048u + (unsigned)((u.pn & 7) * BM + wc * 32 + 8 * fq)) * 2u;
        const unsigned long long* sp = ssq + u.pm * BM;
#pragma unroll
        for (int ai = 0; ai < 2; ++ai)
#pragma unroll
            for (int m = 0; m < 4; ++m) { const float r = __builtin_amdgcn_rsqf((float)*(const unsigned long long*)((const char*)sp + (unsigned)(rl + ai * HALF + m * 16) * 8u) * (1.0f / (256.0f * 1048576.0f)) + RMS_EPS);
#pragma unroll
                for (int bj = 0; bj < 2; ++bj) *(u32x4*)(base + (off0 + (unsigned)((ai * HALF + m * 16) * 2048 + bj * HALF) * 2u)) = pack8(acc[ai][bj][m][0] * r, acc[ai][bj][m][1] * r); }
    }
};
struct EpiQ {
    static constexpr bool PERM = true, AFTER_DRAIN = false;
    bf16_t* QR; const unsigned long long* ssq;
    __device__ __forceinline__ void operator()(const f32x4 (&acc)[2][2][4][2], const Unit& u, int wr, int wc, int fr, int fq) const {
        const int rl = wr * 64 + fr;
        const unsigned off0 = ((unsigned)(u.pm * BM + rl) * 3072u + (unsigned)(u.pn * BM + wc * 32 + 8 * fq)) * 2u;
        const unsigned long long* sp = ssq + u.pm * BM;
#pragma unroll
        for (int ai = 0; ai < 2; ++ai)
#pragma unroll
            for (int m = 0; m < 4; ++m) { const float r = __builtin_amdgcn_rsqf((float)*(const unsigned long long*)((const char*)sp + (unsigned)(rl + ai * HALF + m * 16) * 8u) * (1.0f / (512.0f * 1048576.0f)) + RMS_EPS);
#pragma unroll
                for (int bj = 0; bj < 2; ++bj) *(u32x4*)((char*)QR + (off0 + (unsigned)((ai * HALF + m * 16) * 3072 + bj * HALF) * 2u)) = pack8(acc[ai][bj][m][0] * r, acc[ai][bj][m][1] * r); }
    }
};
template <bool ADD> struct EpiGate {
    static constexpr bool PERM = true, AFTER_DRAIN = false;
    bf16_t* Y; const bf16_t* Yin; const bf16_t* G; int ldg;
    __device__ __forceinline__ void operator()(const f32x4 (&acc)[2][2][4][2], const Unit& u, int wr, int wc, int fr, int fq) const {
        const int row0 = u.pm * BM + wr * 64 + fr, col0 = u.pn * BM + wc * 32 + 8 * fq;
#pragma unroll
        for (int ai = 0; ai < 2; ++ai)
#pragma unroll
            for (int m = 0; m < 4; ++m) { const int row = row0 + ai * HALF + m * 16;
#pragma unroll
                for (int bj = 0; bj < 2; ++bj) { const int col = col0 + bj * HALF;
                    const u32x4 g = *(const u32x4*)(G + (size_t)row * ldg + col); f32x4 v0 = acc[ai][bj][m][0], v1 = acc[ai][bj][m][1];
                    v0[0] *= sigmoidf_(bf_lo(g.x)); v0[1] *= sigmoidf_(bf_hi(g.x)); v0[2] *= sigmoidf_(bf_lo(g.y)); v0[3] *= sigmoidf_(bf_hi(g.y));
                    v1[0] *= sigmoidf_(bf_lo(g.z)); v1[1] *= sigmoidf_(bf_hi(g.z)); v1[2] *= sigmoidf_(bf_lo(g.w)); v1[3] *= sigmoidf_(bf_hi(g.w));
                    if (ADD) { const u32x4 y = *(const u32x4*)(Yin + (size_t)row * 2048 + col);
                        v0[0] += bf_lo(y.x); v0[1] += bf_hi(y.x); v0[2] += bf_lo(y.y); v0[3] += bf_hi(y.y); v1[0] += bf_lo(y.z); v1[1] += bf_hi(y.z); v1[2] += bf_lo(y.w); v1[3] += bf_hi(y.w); }
                    *(u32x4*)(Y + (size_t)row * 2048 + col) = pack8(v0, v1); } }
    }
};
struct EpiRes {
    static constexpr bool PERM = false, AFTER_DRAIN = false;
    const float* base; float* out; const float* gates;
    const float* cbase; float* cout;
    __device__ __forceinline__ void operator()(const f32x4 (&acc)[2][2][4][2], const Unit& u, int wr, int wc, int fr, int fq) const {
        const bool isc = u.pm >= 64; const int bi = isc ? 4 : (u.pm >> 4);
        const float* gp = gates + (size_t)bi * (6 * 2048) + 2 * 2048; const float* bp = isc ? cbase : base; float* op = isc ? cout : out;
        const int row0 = (isc ? (u.pm - 64) : u.pm) * BM + wr * 64 + fr, col0 = u.pn * BM + wc * 32 + 4 * fq;
        f32x4 gv[2][2];
#pragma unroll
        for (int bj = 0; bj < 2; ++bj)
#pragma unroll
            for (int n = 0; n < 2; ++n) gv[bj][n] = *(const f32x4*)(gp + col0 + bj * HALF + n * 16);
#pragma unroll
        for (int ai = 0; ai < 2; ++ai)
#pragma unroll
            for (int m = 0; m < 4; ++m) { const size_t off = (size_t)(row0 + ai * HALF + m * 16) * 2048 + col0;
#pragma unroll
                for (int bj = 0; bj < 2; ++bj)
#pragma unroll
                    for (int n = 0; n < 2; ++n) { const f32x4 b = *(const f32x4*)(bp + off + bj * HALF + n * 16); *(f32x4*)(op + off + bj * HALF + n * 16) = b + gv[bj][n] * acc[ai][bj][m][n]; } }
    }
};
struct EpiF32 {
    static constexpr bool PERM = false, AFTER_DRAIN = false;
    float* C; int ldc;
    __device__ __forceinline__ void operator()(const f32x4 (&acc)[2][2][4][2], const Unit& u, int wr, int wc, int fr, int fq) const {
        const int row0 = u.pm * BM + wr * 64 + fr, col0 = u.pn * BM + wc * 32 + 4 * fq;
#pragma unroll
        for (int ai = 0; ai < 2; ++ai)
#pragma unroll
            for (int m = 0; m < 4; ++m) { float* rowp = C + (size_t)(row0 + ai * HALF + m * 16) * ldc + col0;
#pragma unroll
                for (int bj = 0; bj < 2; ++bj)
#pragma unroll
                    for (int n = 0; n < 2; ++n) *(f32x4*)(rowp + bj * HALF + n * 16) = acc[ai][bj][m][n]; }
    }
};

template <class Epi, class Sched, bool ALIGN_EPI = false, bool SP2 = false>
__device__ __forceinline__ void gemm_phase(PG8_LAS unsigned char* lds, const Gemm g, const Sched& S, const Epi& E) {
    int tid_o = threadIdx.x; asm volatile("" : "+v"(tid_o));
    const int tid = tid_o, wid = __builtin_amdgcn_readfirstlane(tid >> 6), lane = tid & 63, wr = wid >> 2, wc = wid & 3, fr = lane & 15, fq = lane >> 4;
    int K_o = g.K; asm volatile("" : "+s"(K_o));
    const int K = K_o, nt = K / BK;
    unsigned voffA[2], voffB[2];
#pragma unroll
    for (int i = 0; i < 2; ++i) { int R, C; stage_rc(tid * 16 + i * 8192, R, C); const int Rb = Epi::PERM ? ((R & ~31) + perm32(R & 31)) : R;
        voffA[i] = (unsigned)(R * g.lda + C) * 2u; voffB[i] = (unsigned)(Rb * g.ldb + C) * 2u; }
    const size_t kstep = (size_t)(BK * 2);
    const size_t hstepA = (size_t)HALF * g.lda * 2, hstepB = (size_t)HALF * g.ldb * 2;
    const size_t tstepA = 2 * hstepA, tstepB = 2 * hstepB;
    const unsigned ldsw = (unsigned)wid * 1024u;
    const int aoff = lds_byte(wr * 64 + fr, fq * 8), boff = lds_byte(wc * 32 + fr, fq * 8);
#define PG8_SA(b, h) (((b) * 2 + (h)) * HTB)
#define PG8_SB(b, h) ((4 + (b) * 2 + (h)) * HTB)
#define PG8_STAGE(bufoff, gbase, voff) do { _Pragma("unroll") for (int _i = 0; _i < 2; ++_i) \
        __builtin_amdgcn_global_load_lds((const unsigned*)((const char*)(gbase) + (voff)[_i]), (PG8_LAS unsigned*)(lds + (bufoff) + ldsw + _i * 8192), 16, 0, 0); } while (0)
#define PG8_LDA(dst, b, h) do { _Pragma("unroll") for (int m = 0; m < 4; ++m) _Pragma("unroll") for (int k = 0; k < 2; ++k) dst[m][k] = *(const PG8_LAS bf16x8*)(lds + PG8_SA(b, h) + aoff + m * 2048 + k * 1024); } while (0)
#define PG8_LDB(dst, b, h) do { _Pragma("unroll") for (int n = 0; n < 2; ++n) _Pragma("unroll") for (int k = 0; k < 2; ++k) dst[n][k] = *(const PG8_LAS bf16x8*)(lds + PG8_SB(b, h) + boff + n * 2048 + k * 1024); } while (0)
#define PG8_MMA(ai, bj, At, Bt) do { __builtin_amdgcn_s_setprio(1); _Pragma("unroll") for (int m = 0; m < 4; ++m) _Pragma("unroll") for (int n = 0; n < 2; ++n) _Pragma("unroll") for (int k = 0; k < 2; ++k) \
        acc[ai][bj][m][n] = __builtin_amdgcn_mfma_f32_16x16x32_bf16(Bt[n][k], At[m][k], acc[ai][bj][m][n], 0, 0, 0); __builtin_amdgcn_s_setprio(0); } while (0)
#define PG8_WAIT_V(n) asm volatile("s_waitcnt vmcnt(" #n ")" ::: "memory")
#define PG8_WAIT_L(n) asm volatile("s_waitcnt lgkmcnt(" #n ")" ::: "memory")
#define PG8_BAR __builtin_amdgcn_s_barrier()
#define PG8_SCHED __builtin_amdgcn_sched_barrier(0)
    Unit cur, nxt; int ui = 0;
    if (!S.next(0, cur)) return;
    f32x4 acc[2][2][4][2];
#pragma unroll
    for (int a = 0; a < 2; ++a)
#pragma unroll
        for (int b = 0; b < 2; ++b)
#pragma unroll
            for (int m = 0; m < 4; ++m)
#pragma unroll
                for (int n = 0; n < 2; ++n) acc[a][b][m][n] = (f32x4){0.f, 0.f, 0.f, 0.f};
    bf16x8 At[4][2], B0[2][2], B1[2][2];
    const char* cA = (const char*)g.A + (size_t)cur.pm * tstepA; const char* cB = (const char*)g.Bt + (size_t)cur.pn * tstepB;
    S.a_ready(cur);
    if constexpr (SP2) {
        PG8_STAGE(PG8_SB(0, 0), cB, voffB); PG8_STAGE(PG8_SB(0, 1), cB + hstepB, voffB); PG8_STAGE(PG8_SA(0, 0), cA, voffA); PG8_STAGE(PG8_SA(0, 1), cA + hstepA, voffA);
        if (wr == 1) PG8_BAR;
        PG8_WAIT_V(2); PG8_BAR;
        PG8_STAGE(PG8_SB(1, 0), cB + kstep, voffB); PG8_STAGE(PG8_SA(1, 0), cA + kstep, voffA); PG8_STAGE(PG8_SB(1, 1), cB + hstepB + kstep, voffB);
        PG8_WAIT_V(6); PG8_BAR;
    } else {
        PG8_STAGE(PG8_SB(0, 0), cB, voffB); PG8_STAGE(PG8_SA(0, 0), cA, voffA); PG8_STAGE(PG8_SB(0, 1), cB + hstepB, voffB); PG8_STAGE(PG8_SA(0, 1), cA + hstepA, voffA);
        if (wr == 1) PG8_BAR;
        PG8_WAIT_V(4); PG8_BAR;
        PG8_STAGE(PG8_SB(1, 0), cB + kstep, voffB); PG8_STAGE(PG8_SA(1, 0), cA + kstep, voffA); PG8_STAGE(PG8_SB(1, 1), cB + hstepB + kstep, voffB);
        PG8_WAIT_V(6); PG8_BAR;
    }
    for (;;) {
        const bool has_next = S.next(ui + 1, nxt);
        const char* nA = has_next ? (const char*)g.A + (size_t)nxt.pm * tstepA : cA; const char* nB = has_next ? (const char*)g.Bt + (size_t)nxt.pn * tstepB : cB;
        for (int t = 0; t < nt; t += 2) {
            const bool last = (t == nt - 2);
            const char* a1 = cA + (size_t)(t + 1) * kstep;
            const char* a2 = last ? nA : cA + (size_t)(t + 2) * kstep; const char* b2 = last ? nB : cB + (size_t)(t + 2) * kstep;
            const char* a3 = a2 + kstep; const char* b3 = b2 + kstep;
            if (last && has_next) S.a_ready(nxt);
            if constexpr (SP2) {
            PG8_LDB(B0, 0, 0); PG8_LDB(B1, 0, 1); PG8_SCHED; PG8_LDA(At, 0, 0); PG8_STAGE(PG8_SA(1, 1), a1 + hstepA, voffA);
            PG8_WAIT_V(8); PG8_WAIT_L(0); PG8_BAR; PG8_MMA(0, 0, At, B0); PG8_MMA(0, 1, At, B1); PG8_BAR; PG8_SCHED;
            PG8_LDA(At, 0, 1); PG8_STAGE(PG8_SB(0, 0), b2, voffB); PG8_STAGE(PG8_SB(0, 1), b2 + hstepB, voffB); PG8_STAGE(PG8_SA(0, 0), a2, voffA);
            PG8_WAIT_V(8); PG8_WAIT_L(0); PG8_BAR; PG8_MMA(1, 0, At, B0); PG8_MMA(1, 1, At, B1); PG8_BAR; PG8_SCHED;
            PG8_LDB(B0, 1, 0); PG8_LDB(B1, 1, 1); PG8_SCHED; PG8_LDA(At, 1, 0); PG8_STAGE(PG8_SA(0, 1), a2 + hstepA, voffA);
            PG8_WAIT_V(8); PG8_WAIT_L(0); PG8_BAR; PG8_MMA(0, 0, At, B0); PG8_MMA(0, 1, At, B1); PG8_BAR; PG8_SCHED;
            PG8_LDA(At, 1, 1); PG8_STAGE(PG8_SB(1, 0), b3, voffB); PG8_STAGE(PG8_SB(1, 1), b3 + hstepB, voffB); PG8_STAGE(PG8_SA(1, 0), a3, voffA);
            PG8_WAIT_V(8); PG8_WAIT_L(0); PG8_BAR; PG8_MMA(1, 0, At, B0); PG8_MMA(1, 1, At, B1); PG8_BAR; PG8_SCHED;
            } else {
            PG8_LDB(B0, 0, 0); PG8_SCHED; PG8_LDA(At, 0, 0); PG8_STAGE(PG8_SA(1, 1), a1 + hstepA, voffA);
            PG8_WAIT_L(8); PG8_BAR; PG8_WAIT_L(0); PG8_MMA(0, 0, At, B0); PG8_BAR; PG8_SCHED;
            PG8_LDB(B1, 0, 1); PG8_STAGE(PG8_SB(0, 0), b2, voffB);
            PG8_BAR; PG8_WAIT_L(0); PG8_MMA(0, 1, At, B1); PG8_BAR;
            PG8_LDA(At, 0, 1); PG8_STAGE(PG8_SA(0, 0), a2, voffA);
            PG8_BAR; PG8_WAIT_L(0); PG8_MMA(1, 0, At, B0); PG8_BAR; PG8_SCHED;
            PG8_STAGE(PG8_SB(0, 1), b2 + hstepB, voffB);
            PG8_WAIT_V(6); PG8_BAR; PG8_MMA(1, 1, At, B1); PG8_BAR;
            PG8_LDB(B0, 1, 0); PG8_SCHED; PG8_LDA(At, 1, 0); PG8_STAGE(PG8_SA(0, 1), a2 + hstepA, voffA);
            PG8_WAIT_L(8); PG8_BAR; PG8_WAIT_L(0); PG8_MMA(0, 0, At, B0); PG8_BAR; PG8_SCHED;
            PG8_LDB(B1, 1, 1); PG8_STAGE(PG8_SB(1, 0), b3, voffB);
            PG8_BAR; PG8_WAIT_L(0); PG8_MMA(0, 1, At, B1); PG8_BAR;
            PG8_LDA(At, 1, 1); PG8_STAGE(PG8_SA(1, 0), a3, voffA);
            PG8_BAR; PG8_WAIT_L(0); PG8_MMA(1, 0, At, B0); PG8_BAR; PG8_SCHED;
            PG8_STAGE(PG8_SB(1, 1), b3 + hstepB, voffB);
            PG8_WAIT_V(6); PG8_BAR; PG8_MMA(1, 1, At, B1); PG8_BAR;
            }
        }
        if constexpr (ALIGN_EPI) { if (wr == 0) PG8_BAR; }
        if constexpr (!Epi::AFTER_DRAIN) { E(acc, cur, wr, wc, fr, fq); S.done(cur); }
        if (!has_next) break;
#pragma unroll
        for (int a = 0; a < 2; ++a)
#pragma unroll
            for (int b = 0; b < 2; ++b)
#pragma unroll
                for (int m = 0; m < 4; ++m)
#pragma unroll
                    for (int n = 0; n < 2; ++n) acc[a][b][m][n] = (f32x4){0.f, 0.f, 0.f, 0.f};
        cur = nxt; cA = nA; cB = nB; ++ui;
        if constexpr (ALIGN_EPI) { if (wr == 1) PG8_BAR; }
    }
    PG8_WAIT_V(0);
    if constexpr (!ALIGN_EPI) { if (wr == 0) PG8_BAR; }
    PG8_BAR;
    if constexpr (Epi::AFTER_DRAIN) { E.fused(acc, cur, wr, wc, fr, fq, lds, wid, lane); S.done(cur); }
#undef PG8_SA
#undef PG8_SB
#undef PG8_STAGE
#undef PG8_LDA
#undef PG8_LDB
#undef PG8_MMA
#undef PG8_WAIT_V
#undef PG8_WAIT_L
#undef PG8_BAR
#undef PG8_SCHED
}
}
namespace att {
using bf16x8 = __attribute__((ext_vector_type(8))) short;
using s16x4  = __attribute__((ext_vector_type(4))) short;
using f32x16 = __attribute__((ext_vector_type(16))) float;
using u32x4  = __attribute__((ext_vector_type(4))) unsigned;
typedef unsigned short bf16_t;
constexpr int DQK = 192, DV = 128, NW = 8, QBLK = 32, KVBLK = 64, ND0 = DQK / 16;
constexpr float SCALE = 0.07216878364870322f;
constexpr float THR = 8.f;
constexpr int LDQ = 3072, LDK = 3072, LDV = 2048, LDO = 2048;
constexpr int SHM_V = KVBLK * DV * 2, SHM_K = KVBLK * DQK * 2, SHM_WS = 2 * SHM_V + 2 * SHM_K, SHM_QR = SHM_WS + NW * 64 * 4, SHM_ATTN = SHM_QR + NW * 4096;
#define ATT_KSWZ(row, colB) ((row) * 384 + ((colB) ^ (((row) & 7) << 4)))
#define ATT_SBAR() __builtin_amdgcn_sched_barrier(0)
__device__ __forceinline__ int crow(int r, int hi) { return (r & 3) + 8 * (r >> 2) + 4 * hi; }
__device__ __forceinline__ unsigned cvtpk(float lo, float hi) { unsigned r; asm volatile("v_cvt_pk_bf16_f32 %0, %1, %2" : "=v"(r) : "v"(lo), "v"(hi)); return r; }
__device__ __forceinline__ void partialSM(f32x16& p0, f32x16& p1, float& m_reg, float& mn, float& alpha) {
  constexpr float C = SCALE * 1.4426950408889634f;
  float pmax = p0[0];
#pragma unroll
  for (int r = 1; r < 16; ++r) pmax = fmaxf(pmax, p0[r]);
#pragma unroll
  for (int r = 0; r < 16; ++r) pmax = fmaxf(pmax, p1[r]);
  { auto rr = __builtin_amdgcn_permlane32_swap(__float_as_uint(pmax), __float_as_uint(pmax), false, false);
    pmax = fmaxf(__uint_as_float(rr[0]), __uint_as_float(rr[1])); }
  if (__builtin_expect(__all(pmax - m_reg <= THR / SCALE), 1)) { mn = m_reg; alpha = 1.f; }
  else { mn = fmaxf(m_reg, pmax); alpha = __builtin_amdgcn_exp2f((m_reg - mn) * C); m_reg = mn; }
  float mnC = -mn * C;
#pragma unroll
  for (int r = 0; r < 16; ++r) p0[r] = fmaf(p0[r], C, mnC);
#pragma unroll
  for (int r = 0; r < 16; ++r) p1[r] = fmaf(p1[r], C, mnC);
#pragma unroll
  for (int r = 0; r < 16; ++r) p0[r] = __builtin_amdgcn_exp2f(p0[r]);
}
__device__ __forceinline__ void finishSM(f32x16& p0, f32x16& p1, float alpha, float& l_reg, bf16x8& pa0, bf16x8& pa1, bf16x8& pa2, bf16x8& pa3) {
#pragma unroll
  for (int r = 0; r < 16; ++r) p1[r] = __builtin_amdgcn_exp2f(p1[r]);
  float ps = 0;
#pragma unroll
  for (int r = 0; r < 16; ++r) ps += p0[r];
#pragma unroll
  for (int r = 0; r < 16; ++r) ps += p1[r];
  { auto rr = __builtin_amdgcn_permlane32_swap(__float_as_uint(ps), __float_as_uint(ps), false, false);
    ps = __uint_as_float(rr[0]) + __uint_as_float(rr[1]); }
  l_reg = l_reg * alpha + ps;
#define ATT_PK4(P, BASE, OUT) do { unsigned a0 = cvtpk(P[BASE + 0], P[BASE + 1]), a1 = cvtpk(P[BASE + 2], P[BASE + 3]);   \
    unsigned b0 = cvtpk(P[BASE + 4], P[BASE + 5]), b1 = cvtpk(P[BASE + 6], P[BASE + 7]);                              \
    auto r0 = __builtin_amdgcn_permlane32_swap(a0, b0, false, false); auto r1 = __builtin_amdgcn_permlane32_swap(a1, b1, false, false); \
    u32x4 w = {r0[0], r1[0], r0[1], r1[1]}; OUT = *reinterpret_cast<bf16x8*>(&w); } while (0)
  ATT_PK4(p0, 0, pa0); ATT_PK4(p0, 8, pa1); ATT_PK4(p1, 0, pa2); ATT_PK4(p1, 8, pa3);
#undef ATT_PK4
}
__device__ __forceinline__ void qkt(f32x16& p0, f32x16& p1, const char* Ks, const bf16x8* qr, const char* qrl, int r32, int hi) {
  p0 = f32x16{}; p1 = f32x16{};
#pragma unroll
  for (int d0 = 0; d0 < ND0; ++d0) { const int cb = (d0 * 16 + hi * 8) * 2;
    bf16x8 b0 = *reinterpret_cast<const bf16x8*>(Ks + ATT_KSWZ(r32, cb));
    bf16x8 b1 = *reinterpret_cast<const bf16x8*>(Ks + ATT_KSWZ(32 + r32, cb));
    const bf16x8 q = (d0 < 8) ? qr[d0 < 8 ? d0 : 0] : *reinterpret_cast<const bf16x8*>(qrl + (d0 - 8) * 1024);
    p0 = __builtin_amdgcn_mfma_f32_32x32x16_bf16(b0, q, p0, 0, 0, 0);
    p1 = __builtin_amdgcn_mfma_f32_32x32x16_bf16(b1, q, p1, 0, 0, 0); }
}
__device__ __forceinline__ int v_st(int k, int c) { const int kk = (k & ~0xC) | ((k & 4) << 1) | ((k & 8) >> 1); return ((kk >> 3) * 4 + (c >> 5)) * 512 + ((kk & 7) * 32 + (c & 31)) * 2; }
__device__ __forceinline__ int v_rd_base(int lane) { return ((lane & 3) << 3) | (((lane >> 2) & 3) << 6) | (((lane >> 4) & 1) << 5) | (((lane >> 5) & 1) << 8); }
constexpr int v_rd_off(int d0, int ks, int half) { return d0 * 512 + ks * 4096 + half * 2048; }
template <int OFF> __device__ __forceinline__ s16x4 tr_read(int vb) {
  s16x4 r; asm volatile("ds_read_b64_tr_b16 %0, %1 offset:%2" : "=&v"(r) : "v"(vb), "i"(OFF) : "memory"); return r;
}
template <int D0> __device__ __forceinline__ void pv_one(f32x16& od, int vb, bf16x8 pa0, bf16x8 pa1, bf16x8 pa2, bf16x8 pa3) {
  const s16x4 l0 = tr_read<v_rd_off(D0, 0, 0)>(vb), h0 = tr_read<v_rd_off(D0, 0, 1)>(vb), l1 = tr_read<v_rd_off(D0, 1, 0)>(vb), h1 = tr_read<v_rd_off(D0, 1, 1)>(vb);
  const s16x4 l2 = tr_read<v_rd_off(D0, 2, 0)>(vb), h2 = tr_read<v_rd_off(D0, 2, 1)>(vb), l3 = tr_read<v_rd_off(D0, 3, 0)>(vb), h3 = tr_read<v_rd_off(D0, 3, 1)>(vb);
  asm volatile("s_waitcnt lgkmcnt(0)" ::: "memory"); ATT_SBAR();
#define ATT_PK(L, H) (bf16x8){L[0], L[1], L[2], L[3], H[0], H[1], H[2], H[3]}
  od = __builtin_amdgcn_mfma_f32_32x32x16_bf16(pa0, ATT_PK(l0, h0), od, 0, 0, 0);
  od = __builtin_amdgcn_mfma_f32_32x32x16_bf16(pa1, ATT_PK(l1, h1), od, 0, 0, 0);
  od = __builtin_amdgcn_mfma_f32_32x32x16_bf16(pa2, ATT_PK(l2, h2), od, 0, 0, 0);
  od = __builtin_amdgcn_mfma_f32_32x32x16_bf16(pa3, ATT_PK(l3, h3), od, 0, 0, 0);
#undef ATT_PK
}
__device__ __forceinline__ void pv_d0(f32x16* o, int vb, bf16x8 pa0, bf16x8 pa1, bf16x8 pa2, bf16x8 pa3) {
  pv_one<0>(o[0], vb, pa0, pa1, pa2, pa3); pv_one<1>(o[1], vb, pa0, pa1, pa2, pa3); pv_one<2>(o[2], vb, pa0, pa1, pa2, pa3); pv_one<3>(o[3], vb, pa0, pa1, pa2, pa3);
}
__device__ __forceinline__ void attn_unit(const bf16_t* __restrict__ Qb, const bf16_t* __restrict__ Kh, const bf16_t* __restrict__ Vh, bf16_t* __restrict__ Ob, int seq, char* lds) {
  int tid_o = threadIdx.x; asm volatile("" : "+v"(tid_o));
  const int tid = tid_o, wid = tid >> 6, lane = tid & 63, r32 = lane & 31, hi = lane >> 5;
  char* V_lds = lds; char* K_lds = lds + 2 * SHM_V;
  float* ws = (float*)(lds + SHM_WS) + wid * 64; char* qrl = lds + SHM_QR + wid * 4096 + lane * 16; float* li_l = ws; float* al_l = ws + 32;
  float m_reg = -1e30f, l_reg = 0; f32x16 o[4] = {}; bf16x8 qr[8];
  const bf16_t* Qw = Qb + (long)(wid * QBLK + r32) * LDQ + hi * 8;
#pragma unroll
  for (int d0 = 0; d0 < 8; ++d0) qr[d0] = *reinterpret_cast<const bf16x8*>(Qw + d0 * 16);
#pragma unroll
  for (int d0 = 8; d0 < ND0; ++d0) *reinterpret_cast<bf16x8*>(qrl + (d0 - 8) * 1024) = *reinterpret_cast<const bf16x8*>(Qw + d0 * 16);
  const int sr = tid >> 4, sc = (tid & 15) * 8, vst0 = v_st(sr, sc), vst1 = vst0 + 8192;
  const int kst0 = ATT_KSWZ(sr, sc * 2), kr2 = tid >> 3, kc2 = 128 + (tid & 7) * 8, kst2 = ATT_KSWZ(kr2, kc2 * 2);
  const int vb0 = (int)(uintptr_t)V_lds + v_rd_base(lane);
  bf16x8 vs0, vs1, ks0, ks1, ks2;
  const unsigned voff0 = (unsigned)(sr * LDV + sc) * 2u, koff0 = (unsigned)(sr * LDK + sc) * 2u, koff2 = (unsigned)(kr2 * LDK + kc2) * 2u;
#define ATT_SLOAD(k0) do { const char* vt_ = (const char*)Vh + (size_t)(k0) * (LDV * 2); const char* kt_ = (const char*)Kh + (size_t)(k0) * (LDK * 2); \
    vs0 = *reinterpret_cast<const bf16x8*>(vt_ + voff0); vs1 = *reinterpret_cast<const bf16x8*>(vt_ + 32 * LDV * 2 + voff0); \
    ks0 = *reinterpret_cast<const bf16x8*>(kt_ + koff0); ks1 = *reinterpret_cast<const bf16x8*>(kt_ + 32 * LDK * 2 + koff0); \
    ks2 = *reinterpret_cast<const bf16x8*>(kt_ + koff2); } while (0)
#define ATT_SWRITE(b) do { *(bf16x8*)(V_lds + (b) * SHM_V + vst0) = vs0; *(bf16x8*)(V_lds + (b) * SHM_V + vst1) = vs1; \
    *(bf16x8*)(K_lds + (b) * SHM_K + kst0) = ks0; *(bf16x8*)(K_lds + (b) * SHM_K + kst0 + 32 * 384) = ks1; *(bf16x8*)(K_lds + (b) * SHM_K + kst2) = ks2; } while (0)
#define ATT_SWAIT() asm volatile("s_waitcnt vmcnt(0)" ::: "memory")
#define ATT_RESC(a) do { if (__any((a) < 1.f)) { if (hi == 0) al_l[r32] = (a); asm volatile("s_waitcnt lgkmcnt(0)" ::: "memory"); \
    _Pragma("unroll") for (int d = 0; d < 4; ++d) _Pragma("unroll") for (int r = 0; r < 16; ++r) o[d][r] *= al_l[crow(r, hi)]; } } while (0)
  f32x16 pA0, pA1, pB0, pB1; float mnA, mnB, alA, alB; bf16x8 pa0, pa1, pa2, pa3; const int NT = seq / KVBLK;
  ATT_SLOAD(0); ATT_SWAIT(); ATT_SWRITE(0); __syncthreads();
  qkt(pA0, pA1, K_lds, qr, qrl, r32, hi); partialSM(pA0, pA1, m_reg, mnA, alA);
  ATT_SLOAD(KVBLK);
  ATT_SWAIT(); ATT_SWRITE(1); __syncthreads();
  for (int j = 1; j + 1 < NT; j += 2) {
    ATT_SBAR(); qkt(pB0, pB1, K_lds + SHM_K, qr, qrl, r32, hi);
    finishSM(pA0, pA1, alA, l_reg, pa0, pa1, pa2, pa3); ATT_SBAR();
    ATT_SLOAD((j + 1) * KVBLK); ATT_SBAR();
    pv_d0(o, vb0, pa0, pa1, pa2, pa3); partialSM(pB0, pB1, m_reg, mnB, alB);
    __syncthreads(); ATT_SWAIT(); ATT_SWRITE(0);
    ATT_RESC(alB); __syncthreads();
    ATT_SBAR(); qkt(pA0, pA1, K_lds, qr, qrl, r32, hi);
    finishSM(pB0, pB1, alB, l_reg, pa0, pa1, pa2, pa3); ATT_SBAR();
    ATT_SLOAD((j + 2) * KVBLK); ATT_SBAR();
    pv_d0(o, vb0 + SHM_V, pa0, pa1, pa2, pa3); partialSM(pA0, pA1, m_reg, mnA, alA);
    __syncthreads(); ATT_SWAIT(); ATT_SWRITE(1);
    ATT_RESC(alA); __syncthreads();
  }
  ATT_SBAR(); qkt(pB0, pB1, K_lds + SHM_K, qr, qrl, r32, hi);
  finishSM(pA0, pA1, alA, l_reg, pa0, pa1, pa2, pa3); ATT_SBAR();
  pv_d0(o, vb0, pa0, pa1, pa2, pa3); partialSM(pB0, pB1, m_reg, mnB, alB);
  __syncthreads(); ATT_RESC(alB);
  finishSM(pB0, pB1, alB, l_reg, pa0, pa1, pa2, pa3); ATT_SBAR();
  pv_d0(o, vb0 + SHM_V, pa0, pa1, pa2, pa3);
  if (hi == 0) li_l[r32] = l_reg; asm volatile("s_waitcnt lgkmcnt(0)" ::: "memory");
  float rli[16];
#pragma unroll
  for (int r = 0; r < 16; ++r) rli[r] = __builtin_amdgcn_rcpf(li_l[crow(r, hi)]);
  bf16_t* Ow = Ob + (long)(wid * QBLK) * LDO;
#pragma unroll
  for (int r = 0; r < 16; ++r) { const int orow = crow(r, hi);
#pragma unroll
    for (int d0 = 0; d0 < 4; ++d0) { const float a = o[d0][r] * rli[r]; const float bq = __shfl_xor(a, 1);
      if (!(lane & 1)) *(unsigned*)(Ow + (long)orow * LDO + d0 * 32 + r32) = cvtpk(a, bq); } }
  __syncthreads();
#undef ATT_SLOAD
#undef ATT_SWRITE
#undef ATT_SWAIT
#undef ATT_RESC
}
#undef ATT_SBAR
}
#define LAS __attribute__((address_space(3)))
#define XB_TMO      128
#define XB_XCNT(j)  (256  + 64 * (j))
#define XB_XSUB(j)  (1280 + 64 * (j))
#define XB_XGEN(j)  (2304 + 64 * (j))
#define XB_TOP      3328
#define XB_TOPGEN   3392
#define XCD_BAR_WORDS 3456
#define XB_SPIN_CAP (1u << 18)

__device__ __forceinline__ unsigned xb_ld(unsigned* p)              { return __hip_atomic_load(p, __ATOMIC_RELAXED, __HIP_MEMORY_SCOPE_AGENT); }
__device__ __forceinline__ unsigned xb_add(unsigned* p, unsigned v) { return __hip_atomic_fetch_add(p, v, __ATOMIC_RELAXED, __HIP_MEMORY_SCOPE_AGENT); }
__device__ __forceinline__ unsigned xb_xcc_id() { return (unsigned)__builtin_amdgcn_s_getreg((3 << 11) | 20) & 0xFu; }
#define XB_SPIN(cond, bar) do { unsigned _sp = 0; while (cond) { __builtin_amdgcn_s_sleep(1); \
    if ((++_sp & 255u) == 0u) { if (xb_ld(&(bar)[XB_TMO])) break; if (_sp > XB_SPIN_CAP) { atomicAdd(&(bar)[XB_TMO], 1u); break; } } } } while (0)

struct XcdBarrier {
    unsigned* bar; unsigned x;
    volatile LAS unsigned* st;
};

__device__ __forceinline__ XcdBarrier xcd_barrier_post(unsigned* bar, volatile LAS unsigned* st) {
    XcdBarrier b; b.bar = bar; b.x = xb_xcc_id(); b.st = st;
    if (threadIdx.x == 0) (void)xb_add(&bar[XB_XCNT(b.x)], 1u);
    return b;
}
__device__ __forceinline__ void xcd_barrier_complete(unsigned* bar, unsigned x, unsigned& nloc, unsigned& nx) {
    const unsigned G = gridDim.x * gridDim.y * gridDim.z;
    unsigned sum, cnt, mine, sp = 0u;
    for (;;) {
        sum = 0u; cnt = 0u; mine = 0u;
#pragma unroll
        for (unsigned j = 0; j < 16; ++j) { const unsigned c = xb_ld(&bar[XB_XCNT(j)]); sum += c; cnt += (c > 0u) ? 1u : 0u; mine = (j == x) ? c : mine; }
        if (sum == G) break;
        __builtin_amdgcn_s_sleep(1);
        if ((++sp & 255u) == 0u) { if (xb_ld(&bar[XB_TMO])) break; if (sp > XB_SPIN_CAP) { atomicAdd(&bar[XB_TMO], 1u); break; } }
    }
    nloc = mine > 0u ? mine : 1u; nx = cnt > 0u ? cnt : 1u;
}

__device__ __forceinline__ void xcd_barrier(const XcdBarrier& b) {
    asm volatile("s_waitcnt vmcnt(0)" ::: "memory");
    __syncthreads();
    if (threadIdx.x == 0) {
        unsigned* bar = b.bar;
        __builtin_amdgcn_s_waitcnt(0);
        unsigned nloc = b.st[0], nx = b.st[1];
        if (nloc == 0u) { xcd_barrier_complete(bar, b.x, nloc, nx); b.st[0] = nloc; b.st[1] = nx; }
        const unsigned old = xb_add(&bar[XB_XSUB(b.x)], 1u);
        const unsigned gen = old / nloc;
        if (old + 1u == (gen + 1u) * nloc) {
            __builtin_amdgcn_fence(__ATOMIC_RELEASE, "agent");
            asm volatile("s_waitcnt vmcnt(0)" ::: "memory");
            const unsigned og = xb_add(&bar[XB_TOP], 1u);
            const unsigned tg = og / nx;
            if (og + 1u == (tg + 1u) * nx) xb_add(&bar[XB_TOPGEN], 1u);
            else XB_SPIN(xb_ld(&bar[XB_TOPGEN]) == tg, bar);
            __builtin_amdgcn_fence(__ATOMIC_ACQUIRE, "agent");
            xb_add(&bar[XB_XGEN(b.x)], 1u);
            asm volatile("s_waitcnt vmcnt(0)" ::: "memory");
        } else {
            XB_SPIN(xb_ld(&bar[XB_XGEN(b.x)]) == gen, bar);
            __builtin_amdgcn_fence(__ATOMIC_ACQUIRE, "agent");
            asm volatile("s_waitcnt vmcnt(0)" ::: "memory");
        }
    }
    __syncthreads();
}

constexpr int NWAVES = 8;
constexpr int DM = 2048, NB = 4, SEQ = 4096, CTXL = 256, NLAYER = 2;
constexpr int TL = NB * SEQ, TC = NB * CTXL, TT = TL + TC;
constexpr int KEYS = SEQ + CTXL;
constexpr int NIN = 11072, NINP = 11264;
constexpr int PC_KR = 256, PC_Q = 512, PC_CB = 1024, PC_CC = 3072, PC_CU = 5120, PC_GA = 7168, PC_GB = 9216;
constexpr int NEXP = 16384, PEER_H = 8, TOPK = 16;

constexpr size_t MiB = 1u << 20;
constexpr size_t WS_CTL = 0, CTL_ZERO_BYTES = 2 * MiB;
constexpr size_t WS_ADA = 2 * MiB;
constexpr size_t WS_ROPE = 3 * MiB;
constexpr size_t WS_CTXB = 4 * MiB;
constexpr size_t WS_IDX = 12 * MiB, WS_GW = 21 * MiB;
constexpr size_t WS_W = 30 * MiB, W_LAYER = 81 * MiB;
constexpr size_t WO_IN = 0, WO_Q = 44 * MiB, WO_KV = 47 * MiB, WO_A = 49 * MiB, WO_C = 57 * MiB, WO_O = 65 * MiB, WO_EFF = 73 * MiB;
constexpr size_t WS_UB = 192 * MiB, WS_VB = 256 * MiB;
constexpr size_t WS_P = 320 * MiB;
constexpr size_t WS_KA = 694 * MiB, WS_VA = 796 * MiB;
constexpr size_t WS_KN = 864 * MiB, WS_QR = 932 * MiB;
constexpr size_t WS_HB = 1034 * MiB;
constexpr size_t WS_END = 1102 * MiB;
static_assert(WS_P + (size_t)TT * NINP * 2 <= WS_KA && WS_KA + (size_t)NB * KEYS * 3072 * 2 <= WS_VA && WS_VA + (size_t)NB * KEYS * 2048 * 2 <= WS_KN && WS_KN + (size_t)TT * 2048 * 2 <= WS_QR && WS_QR + (size_t)TT * 3072 * 2 <= WS_HB && WS_HB + (size_t)TT * 2048 * 2 <= WS_END, "d_ws map");
static_assert(WS_W + 2 * W_LAYER <= WS_UB && WS_IDX + (size_t)TT * 128 * 4 <= WS_GW && WS_GW + (size_t)TT * 128 * 4 <= WS_W, "d_ws map 2");
constexpr int CW_BAR = 4096;
constexpr int CW_SSQ = 16384;
static_assert((CW_SSQ + 8 * TT) * 4 <= (int)CTL_ZERO_BYTES, "CTL words inside the memset region");

constexpr int RING_OFF = 0, RING_BYTES = 131072;
constexpr int LDSCTL_OFF = RING_BYTES, MISC_OFF = LDSCTL_OFF + 320;
constexpr int LDS_BYTES = 147456;
typedef unsigned short bf16;
typedef unsigned v4u __attribute__((ext_vector_type(4)));
typedef float f32x4 __attribute__((ext_vector_type(4)));
typedef __bf16 bf16x2_t __attribute__((ext_vector_type(2)));
#define LDS_WAIT() asm volatile("s_waitcnt lgkmcnt(0)" ::: "memory")
__device__ __forceinline__ unsigned f2bf(float f) { unsigned u = __builtin_bit_cast(unsigned, f); return (u + 0x7fffu + ((u >> 16) & 1u)) >> 16; }
__device__ __forceinline__ unsigned pk2(float lo, float hi) { return pg8::cvt_pk_bf16(lo, hi); }
__device__ __forceinline__ float blo(unsigned w) { return __uint_as_float(w << 16); }
__device__ __forceinline__ float bhi(unsigned w) { return __uint_as_float(w & 0xffff0000u); }
__device__ __forceinline__ float dot2bf(unsigned a, unsigned b, float c) { return __builtin_amdgcn_fdot2_f32_bf16(__builtin_bit_cast(bf16x2_t, a), __builtin_bit_cast(bf16x2_t, b), c, false); }
__device__ __forceinline__ float wave_sum(float v) {
#pragma unroll
    for (int o = 1; o < 64; o <<= 1) v += __shfl_xor(v, o);
    return v;
}

struct Frame {
    LAS unsigned char* lds;
    volatile LAS unsigned* MISC;
    unsigned* ctl;
    int tid, lane, wave;
    int vcu, G;
};
struct Args { const float* in[23]; float* out; unsigned char* ws; int ph_lo, ph_hi, li, pad; };

__device__ __forceinline__ void ada_item(Frame& F, const float* c, const float* cctx, const float* wmod, const float* bmod, float* ADA, int item) {
    const int l = item / 96, n0 = (item % 96) * 128;
    LAS float* sc = (LAS float*)(F.lds);
    LAS float* red = (LAS float*)(F.lds + 40960);
    for (int i = F.tid; i < 5 * 2048; i += 512) { const float v = (i < 4 * 2048) ? c[i] : cctx[i - 4 * 2048]; sc[i] = v / (1.0f + __expf(-v)); }
    __syncthreads();
    const float* wp = wmod + (size_t)l * 2048 * 12288 + n0 + 2 * F.lane;
    float a[5][2];
#pragma unroll
    for (int r = 0; r < 5; ++r) { a[r][0] = 0.f; a[r][1] = 0.f; }
    const int kb = F.wave * 256;
#pragma unroll 4
    for (int k = 0; k < 256; ++k) { const float2 w = *(const float2*)(wp + (size_t)(kb + k) * 12288);
#pragma unroll
        for (int r = 0; r < 5; ++r) { const float s = sc[r * 2048 + kb + k]; a[r][0] += s * w.x; a[r][1] += s * w.y; } }
#pragma unroll
    for (int r = 0; r < 5; ++r) { red[(F.wave * 5 + r) * 128 + 2 * F.lane] = a[r][0]; red[(F.wave * 5 + r) * 128 + 2 * F.lane + 1] = a[r][1]; }
    __syncthreads();
    for (int i = F.tid; i < 5 * 128; i += 512) { const int r = i >> 7, n = i & 127; float s = bmod[l * 12288 + n0 + n];
#pragma unroll
        for (int w = 0; w < 8; ++w) s += red[(w * 5 + r) * 128 + n];
        ADA[((size_t)l * 5 + r) * 12288 + n0 + n] = s; }
    __syncthreads();
}
__device__ __forceinline__ void transpose_item(const float* W, int ldw, int K, bf16* WT, int ndst, int nsrc, int k0, const float* gain, LAS float* scr, int lane) {
#pragma unroll 8
    for (int i = 0; i < 32; ++i) { const int kk = 2 * i + (lane >> 5); float v = 0.f; if (nsrc >= 0) { v = W[(size_t)(k0 + kk) * ldw + nsrc + (lane & 31)]; if (gain) v *= gain[k0 + kk]; } scr[kk * 33 + (lane & 31)] = v; }
    LDS_WAIT(); asm volatile("" ::: "memory");
    const int c = lane & 7;
#pragma unroll
    for (int j = 0; j < 4; ++j) { const int n = (lane >> 3) + 8 * j; const LAS float* s = scr + (8 * c) * 33 + n;
        v4u o; o.x = pk2(s[0 * 33], s[1 * 33]); o.y = pk2(s[2 * 33], s[3 * 33]); o.z = pk2(s[4 * 33], s[5 * 33]); o.w = pk2(s[6 * 33], s[7 * 33]);
        *(v4u*)(WT + (size_t)(ndst + n) * K + k0 + 8 * c) = o; }
    LDS_WAIT(); asm volatile("" ::: "memory");
}
__device__ __forceinline__ void weff_item(Frame& F, const float* wq, const float* sk, bf16* WeffT, int item) {
    const int hp = item >> 5, k0 = (item & 31) * 64;
    LAS float* s_sk = (LAS float*)(F.lds);
    LAS float* s_wq = (LAS float*)(F.lds + 128 * 132 * 4);
    for (int i = F.tid; i < 128 * 32; i += 512) { const int n = i >> 5, d4 = (i & 31) * 4; *(LAS f32x4*)(s_sk + n * 132 + d4) = *(const f32x4*)(sk + ((size_t)hp * 128 + n) * 128 + d4); }
    for (int i = F.tid; i < 64 * 32; i += 512) { const int k = i >> 5, d4 = (i & 31) * 4; *(LAS f32x4*)(s_wq + k * 132 + d4) = *(const f32x4*)(wq + (size_t)(k0 + k) * 2048 + hp * 128 + d4); }
    __syncthreads();
    const int n = F.tid & 127, kg = F.tid >> 7;
    float acc[16];
#pragma unroll
    for (int i = 0; i < 16; ++i) acc[i] = 0.f;
    for (int d4 = 0; d4 < 128; d4 += 4) { const f32x4 a = *(const LAS f32x4*)(s_sk + n * 132 + d4);
#pragma unroll
        for (int i = 0; i < 16; ++i) { const f32x4 b = *(const LAS f32x4*)(s_wq + (kg * 16 + i) * 132 + d4); acc[i] += (a[0] * b[0] + a[1] * b[1]) + (a[2] * b[2] + a[3] * b[3]); } }
    v4u o0, o1; o0.x = pk2(acc[0], acc[1]); o0.y = pk2(acc[2], acc[3]); o0.z = pk2(acc[4], acc[5]); o0.w = pk2(acc[6], acc[7]);
    o1.x = pk2(acc[8], acc[9]); o1.y = pk2(acc[10], acc[11]); o1.z = pk2(acc[12], acc[13]); o1.w = pk2(acc[14], acc[15]);
    bf16* dst = WeffT + (size_t)(hp * 128 + n) * 2048 + k0 + kg * 16; *(v4u*)dst = o0; *(v4u*)(dst + 8) = o1;
    __syncthreads();
}
template <class T> __device__ __forceinline__ T ldu6(const void* base, unsigned off) { return *(const T*)((const char*)base + off); }
__device__ __forceinline__ void norm_mod_row(const float* xrow, const float* gain, const float* shift, const float* scale, bf16* orow, int lane) {
    const unsigned l16 = (unsigned)lane * 16u; f32x4 v[8]; float s = 0.f;
#pragma unroll
    for (int j = 0; j < 8; ++j) { v[j] = ldu6<f32x4>(xrow, l16 + j * 1024); s += (v[j][0] * v[j][0] + v[j][1] * v[j][1]) + (v[j][2] * v[j][2] + v[j][3] * v[j][3]); }
    const float r = __builtin_amdgcn_rsqf(wave_sum(s) * (1.0f / 2048.0f) + pg8::RMS_EPS);
#pragma unroll
    for (int j = 0; j < 8; ++j) { const f32x4 g = ldu6<f32x4>(gain, l16 + j * 1024), sh = ldu6<f32x4>(shift, l16 + j * 1024), sc = ldu6<f32x4>(scale, l16 + j * 1024);
        const f32x4 y = (v[j] * r * g) * (sc + 1.0f) + sh;
        *(unsigned long long*)((char*)orow + (unsigned)lane * 8u + j * 512) = (unsigned long long)pk2(y[0], y[1]) | ((unsigned long long)pk2(y[2], y[3]) << 32); }
}
__device__ __forceinline__ int row_bi(int row) { return row < TL ? (row >> 12) : 4; }

template <int MODE> __device__ __forceinline__ void qk_norm_row(int row, const bf16* KN, const bf16* P, bf16* KA, bf16* QR, const float* gain, const float2* rope, int lane) {
    const int h = lane >> 2, j = lane & 3, e0 = 48 * j;
    v4u w[6];
#pragma unroll
    for (int c = 0; c < 6; ++c) { const int e = e0 + 8 * c;
        if (MODE == 1) w[c] = *(const v4u*)(QR + (size_t)row * 3072 + h * 192 + e);
        else w[c] = (e < 128) ? *(const v4u*)(KN + (size_t)row * 2048 + h * 128 + e) : *(const v4u*)(P + (size_t)row * NINP + PC_KR + (e - 128)); }
    float x[48]; float s = 0.f;
#pragma unroll
    for (int c = 0; c < 6; ++c) { x[8 * c + 0] = blo(w[c].x); x[8 * c + 1] = bhi(w[c].x); x[8 * c + 2] = blo(w[c].y); x[8 * c + 3] = bhi(w[c].y); x[8 * c + 4] = blo(w[c].z); x[8 * c + 5] = bhi(w[c].z); x[8 * c + 6] = blo(w[c].w); x[8 * c + 7] = bhi(w[c].w); }
#pragma unroll
    for (int i = 0; i < 48; ++i) s += x[i] * x[i];
    s += __shfl_xor(s, 1); s += __shfl_xor(s, 2);
    const float r = __builtin_amdgcn_rsqf(s * (1.0f / 192.0f) + pg8::RMS_EPS);
#pragma unroll
    for (int i = 0; i < 48; i += 4) { const f32x4 g = *(const f32x4*)(gain + e0 + i); x[i] *= r * g[0]; x[i + 1] *= r * g[1]; x[i + 2] *= r * g[2]; x[i + 3] *= r * g[3]; }
    if (row < TL) { const int pos = row & 4095;
#pragma unroll
        for (int i = 0; i < 48; i += 2) { const int e = e0 + i; if (e >= 128) { const float2 cs = rope[pos * 32 + ((e - 128) >> 1)]; const float a = x[i], b = x[i + 1]; x[i] = a * cs.x - b * cs.y; x[i + 1] = a * cs.y + b * cs.x; } } }
    bf16* dst = (MODE == 1) ? QR + (size_t)row * 3072 + h * 192 + e0 : KA + (size_t)pg8::key_row(row) * 3072 + h * 192 + e0;
#pragma unroll
    for (int c = 0; c < 6; ++c) { v4u o; o.x = pk2(x[8 * c], x[8 * c + 1]); o.y = pk2(x[8 * c + 2], x[8 * c + 3]); o.z = pk2(x[8 * c + 4], x[8 * c + 5]); o.w = pk2(x[8 * c + 6], x[8 * c + 7]); *(v4u*)(dst + 8 * c) = o; }
}
__device__ __forceinline__ void conv_item(const bf16* P, const float* cw, bf16* CV, int row, int ch) {
    const int pos = row < TL ? (row & 4095) : ((row - TL) & 255), len = row < TL ? SEQ : CTXL;
    const bf16* pr = P + (size_t)row * NINP + ch;
    float z[3][8];
#pragma unroll
    for (int j = 0; j < 3; ++j) { const int p = pos + j - 1; const bool ok = (p >= 0) && (p < len);
        if (ok) { const v4u c = *(const v4u*)(pr + (long)(j - 1) * NINP + PC_CC), u = *(const v4u*)(pr + (long)(j - 1) * NINP + PC_CU);
            z[j][0] = blo(c.x) * blo(u.x); z[j][1] = bhi(c.x) * bhi(u.x); z[j][2] = blo(c.y) * blo(u.y); z[j][3] = bhi(c.y) * bhi(u.y);
            z[j][4] = blo(c.z) * blo(u.z); z[j][5] = bhi(c.z) * bhi(u.z); z[j][6] = blo(c.w) * blo(u.w); z[j][7] = bhi(c.w) * bhi(u.w); }
        else {
#pragma unroll
            for (int i = 0; i < 8; ++i) z[j][i] = 0.f; } }
    const v4u b = *(const v4u*)(pr + PC_CB); const float bg[8] = {blo(b.x), bhi(b.x), blo(b.y), bhi(b.y), blo(b.z), bhi(b.z), blo(b.w), bhi(b.w)};
    float y[8];
#pragma unroll
    for (int i = 0; i < 8; ++i) y[i] = bg[i] * (cw[ch + i] * z[0][i] + cw[2048 + ch + i] * z[1][i] + cw[4096 + ch + i] * z[2][i]);
    v4u o; o.x = pk2(y[0], y[1]); o.y = pk2(y[2], y[3]); o.z = pk2(y[4], y[5]); o.w = pk2(y[6], y[7]);
    *(v4u*)(CV + (size_t)row * 2048 + ch) = o;
}

__device__ __forceinline__ int ord_key(float f) { int k = __float_as_int(f); return k ^ ((k >> 31) & 0x7fffffff); }
__device__ __forceinline__ float ord_val(int k) { return __int_as_float(k ^ ((k >> 31) & 0x7fffffff)); }
#define TOPK_INSERT(T, X) do { int x_ = (X); _Pragma("unroll") for (int i_ = 0; i_ < 16; ++i_) { const int hi_ = max(T[i_], x_); x_ = min(T[i_], x_); T[i_] = hi_; } } while (0)
__device__ __forceinline__ void topk_item(const float* SC, int* IDX, float* GW, int row0, LAS int* lists, int lane) {
#pragma unroll 1
    for (int pp = 0; pp < 2; ++pp) {
        const int L = pp * 64 + lane, tl = L >> 4, hp = L & 15;
        const f32x4* src = (const f32x4*)(SC + (size_t)(row0 + tl) * 2048 + hp * 128);
        int top[16];
#pragma unroll
        for (int i = 0; i < 16; ++i) top[i] = (int)0x80000000;
#pragma unroll 2
        for (int e4 = 0; e4 < 32; ++e4) { const f32x4 v = src[e4];
#pragma unroll
            for (int c = 0; c < 4; ++c) TOPK_INSERT(top, (ord_key(v[c]) & ~0x7F) | (e4 * 4 + c)); }
#pragma unroll
        for (int i = 0; i < 16; ++i) lists[i * 128 + L] = top[i];
    }
    LDS_WAIT(); asm volatile("" ::: "memory");
    const int tl = lane >> 3, h = lane & 7, LA = tl * 16 + 2 * h, LB = LA + 1;
    float va[16], vb[16];
#pragma unroll
    for (int i = 0; i < 16; ++i) { va[i] = ord_val(lists[i * 128 + LA] & ~0x7F); vb[i] = ord_val(lists[i * 128 + LB] & ~0x7F); }
    int best[16];
#pragma unroll
    for (int i = 0; i < 16; ++i) best[i] = (int)0x80000000;
#pragma unroll
    for (int i = 0; i < 16; ++i)
#pragma unroll
        for (int j = 0; j < 16; ++j) if ((i + 1) * (j + 1) <= 16) TOPK_INSERT(best, (ord_key(va[i] + vb[j]) & ~0xFF) | (i << 4) | j);
    float sc[16]; float ssum = 0.f; const float smax = ord_val(best[0] & ~0xFF);
    int ex[16];
#pragma unroll
    for (int k = 0; k < 16; ++k) { const int code = best[k] & 0xFF, i = code >> 4, j = code & 15;
        ex[k] = (lists[i * 128 + LA] & 0x7F) * 128 + (lists[j * 128 + LB] & 0x7F);
        sc[k] = __expf(ord_val(best[k] & ~0xFF) - smax); ssum += sc[k]; }
    const float inv = 1.0f / ssum;
    int* ip = IDX + (size_t)(row0 + tl) * 128 + h * 16; float* gp = GW + (size_t)(row0 + tl) * 128 + h * 16;
#pragma unroll
    for (int k = 0; k < 16; k += 4) { *(int4*)(ip + k) = make_int4(ex[k], ex[k + 1], ex[k + 2], ex[k + 3]); *(f32x4*)(gp + k) = (f32x4){sc[k] * inv, sc[k + 1] * inv, sc[k + 2] * inv, sc[k + 3] * inv}; }
    LDS_WAIT(); asm volatile("" ::: "memory");
}

template <class T> __device__ __forceinline__ T ldu(const void* base, unsigned off) { return *(const T*)((const char*)base + off); }
template <class T> __device__ __forceinline__ void stu(void* base, unsigned off, T v) { *(T*)((char*)base + off) = v; }
__device__ __forceinline__ void peer_row(const bf16* hrow, const int* idx, const float* gw, const bf16* UB, const bf16* VB, float (&out)[32], int lane) {
    const unsigned l16 = (unsigned)lane * 16u;
    v4u hv[4];
#pragma unroll
    for (int j = 0; j < 4; ++j) hv[j] = ldu<v4u>(hrow, l16 + j * 1024);
#pragma unroll
    for (int i = 0; i < 32; ++i) out[i] = 0.f;
    const int mybt = (lane >> 2) & 3; const bool b5 = lane & 32, b4 = lane & 16;
    const unsigned myk4 = (unsigned)(mybt * 4 + ((lane >> 5) & 1) * 2 + ((lane >> 4) & 1)) * 4u;
#pragma unroll 1
    for (int hd = 0; hd < 8; ++hd) {
        const int my_e = ldu<int>(idx + hd * 16, myk4); const float my_g = ldu<float>(gw + hd * 16, myk4);
        float tot = 0.f;
#pragma unroll 1
        for (int bt = 0; bt < 4; ++bt) {
            v4u w[4][4];
#pragma unroll
            for (int e = 0; e < 4; ++e) { const int ei = __builtin_amdgcn_readlane(my_e, bt * 4 + (e >> 1) * 32 + (e & 1) * 16); const bf16* up = UB + (size_t)ei * 2048;
#pragma unroll
                for (int j = 0; j < 4; ++j) w[e][j] = ldu<v4u>(up, l16 + j * 1024); }
            float d[4];
#pragma unroll
            for (int e = 0; e < 4; ++e) { float a0 = 0.f, a1 = 0.f;
#pragma unroll
                for (int j = 0; j < 4; ++j) { a0 = dot2bf(w[e][j].x, hv[j].x, a0); a1 = dot2bf(w[e][j].y, hv[j].y, a1); a0 = dot2bf(w[e][j].z, hv[j].z, a0); a1 = dot2bf(w[e][j].w, hv[j].w, a1); }
                d[e] = a0 + a1; }
            float t2[2], t1;
#pragma unroll
            for (int i = 0; i < 2; ++i) { const float mine = b5 ? d[2 + i] : d[i], send = b5 ? d[i] : d[2 + i]; t2[i] = mine + __shfl_xor(send, 32); }
            { const float mine = b4 ? t2[1] : t2[0], send = b4 ? t2[0] : t2[1]; t1 = mine + __shfl_xor(send, 16); }
            t1 += __shfl_xor(t1, 8); t1 += __shfl_xor(t1, 4); t1 += __shfl_xor(t1, 2); t1 += __shfl_xor(t1, 1);
            tot = (bt == mybt) ? t1 : tot;
        }
        const float wgt = my_g * 0.5f * tot * (1.0f + erff(tot * 0.70710678118654752f));
#pragma unroll 1
        for (int bt = 0; bt < 4; ++bt) {
            v4u w[4][4];
#pragma unroll
            for (int e = 0; e < 4; ++e) { const int ei = __builtin_amdgcn_readlane(my_e, bt * 4 + (e >> 1) * 32 + (e & 1) * 16); const bf16* vp = VB + (size_t)ei * 2048;
#pragma unroll
                for (int j = 0; j < 4; ++j) w[e][j] = ldu<v4u>(vp, l16 + j * 1024); }
#pragma unroll
            for (int e = 0; e < 4; ++e) { const float we = __int_as_float(__builtin_amdgcn_readlane(__float_as_int(wgt), bt * 4 + (e >> 1) * 32 + (e & 1) * 16));
#pragma unroll
                for (int j = 0; j < 4; ++j) { const v4u q = w[e][j];
                    out[8 * j + 0] += we * blo(q.x); out[8 * j + 1] += we * bhi(q.x); out[8 * j + 2] += we * blo(q.y); out[8 * j + 3] += we * bhi(q.y);
                    out[8 * j + 4] += we * blo(q.z); out[8 * j + 5] += we * bhi(q.z); out[8 * j + 6] += we * blo(q.w); out[8 * j + 7] += we * bhi(q.w); } }
        }
    }
}

#if defined(__HIP_DEVICE_COMPILE__)
#define ASSUME_GLOBAL(p) do { __builtin_assume(!__builtin_amdgcn_is_shared((const __attribute__((address_space(0))) void*)(p))); __builtin_assume(!__builtin_amdgcn_is_private((const __attribute__((address_space(0))) void*)(p))); } while (0)
#else
#define ASSUME_GLOBAL(p) do { } while (0)
#endif
__device__ __forceinline__ const float* inp_ptr(const Args& a, int k) { asm volatile("" : "+s"(k)); const float* p = a.in[k]; ASSUME_GLOBAL(p); return p; }
constexpr int NPHASE = 22;
__global__ void __launch_bounds__(NWAVES * 64, 2) fwd_kernel(Args args) {
    extern __shared__ __attribute__((aligned(16))) unsigned char lds[];
    Frame F;
    F.lds = (LAS unsigned char*)lds;
    F.MISC = (volatile LAS unsigned*)(F.lds + MISC_OFF);
    F.tid = threadIdx.x; F.lane = F.tid & 63; F.wave = __builtin_amdgcn_readfirstlane(F.tid >> 6);
    F.G = gridDim.x; { const int bx = blockIdx.x; F.vcu = (F.G % 8 == 0) ? (bx % 8) * (F.G / 8) + bx / 8 : bx; }
    F.ctl = (unsigned*)(args.ws + WS_CTL);
    for (int u = F.tid; u < (LDS_BYTES - LDSCTL_OFF) / 4; u += NWAVES * 64) ((LAS unsigned*)(F.lds + LDSCTL_OFF))[u] = 0u;
    __syncthreads();
    XcdBarrier bar = xcd_barrier_post((unsigned*)(F.ctl + CW_BAR), F.MISC + 8);
    const int lo = args.ph_lo, hi = args.ph_hi;
#define IN(k) (lo <= (k) && (k) < hi)
#ifndef PHMASK
#define PHMASK 0xFFF
#endif
#define EN(b) ((PHMASK >> (b)) & 1)
#define PHASE_BEGIN() int ptid_ = threadIdx.x; asm volatile("" : "+v"(ptid_)); Frame Fp = F; Fp.tid = ptid_; Fp.lane = ptid_ & 63; const int gt = bid * 512 + Fp.tid; (void)gt; \
    size_t oz_ = 0; asm volatile("" : "+s"(oz_)); unsigned char* ws = args.ws + oz_; float* xout = args.out + oz_; (void)xout
#define INP(k_) (args.in[k_] + oz_)
#define WSP(T_, off_) ((T_*)(ws + (off_)))
#define SEAM(k) do { if (IN(k) && IN((k) + 1)) xcd_barrier(bar); } while (0)
    const int gw = F.vcu * NWAVES + F.wave, NGW = F.G * NWAVES, bid = F.vcu;
    const int NGT = F.G * 512;

    if (EN(0) && IN(0)) { PHASE_BEGIN();
        const float* c_in = INP(1); const float* cctx_in = INP(3); const float* w_mod = INP(4); const float* b_mod = INP(5); const float* w_in = INP(7);
        const float* q_a_norm = INP(8); const float* kv_a_norm = INP(9); const float* w_q_up = INP(10); const float* w_kv_up = INP(11);
        const float* w_attn_out = INP(15); const float* w_conv_out = INP(16); const float* w_o = INP(17); const float* w_query = INP(19); const float* sub_keys = INP(20);
        float* ADA = WSP(float, WS_ADA); float2* ROPE = WSP(float2, WS_ROPE);
        for (int it = bid; it < 192; it += F.G) ada_item(Fp, c_in, cctx_in, w_mod, b_mod, ADA, it);
        {   LAS float* scr = (LAS float*)(F.lds + RING_OFF + F.wave * 16384);
            constexpr int I_IN = 32 * 352, I_Q = 8 * 96, I_KV = 4 * 128, I_SQ = 32 * 64, I_L = I_IN + I_Q + I_KV + 3 * I_SQ;
            for (int it = gw; it < 2 * I_L; it += NGW) {
                const int l = it / I_L; int r = it % I_L; bf16* wl = (bf16*)(ws + WS_W + (size_t)l * W_LAYER);
                if (r < I_IN) { const int kb = r / 352, n0 = (r % 352) * 32; const int ns = n0 < 320 ? n0 : (n0 < 512 ? -1 : n0 - 192);
                    transpose_item(w_in + (size_t)l * 2048 * NIN, NIN, 2048, (bf16*)((char*)wl + WO_IN), n0, ns, kb * 64, nullptr, scr, Fp.lane); continue; } r -= I_IN;
                if (r < I_Q) { const int kb = r / 96, n0 = (r % 96) * 32;
                    transpose_item(w_q_up + (size_t)l * 512 * 3072, 3072, 512, (bf16*)((char*)wl + WO_Q), n0, n0, kb * 64, q_a_norm + l * 512, scr, Fp.lane); continue; } r -= I_Q;
                if (r < I_KV) { const int kb = r / 128, n0 = (r % 128) * 32; const int ns = n0 < 2048 ? (n0 >> 7) * 256 + (n0 & 127) : ((n0 - 2048) >> 7) * 256 + 128 + ((n0 - 2048) & 127);
                    transpose_item(w_kv_up + (size_t)l * 256 * 4096, 4096, 256, (bf16*)((char*)wl + WO_KV), n0, ns, kb * 64, kv_a_norm + l * 256, scr, Fp.lane); continue; } r -= I_KV;
                const int m = r / I_SQ; r %= I_SQ; const int kb = r / 64, n0 = (r % 64) * 32;
                const float* src = (m == 0 ? w_attn_out : (m == 1 ? w_conv_out : w_o)) + (size_t)l * 2048 * 2048;
                transpose_item(src, 2048, 2048, (bf16*)((char*)wl + (m == 0 ? WO_A : (m == 1 ? WO_C : WO_O))), n0, n0, kb * 64, nullptr, scr, Fp.lane);
            }
        }
        __syncthreads();
        for (int it = bid; it < 2 * 512; it += F.G) { const int l = it >> 9;
            weff_item(Fp, w_query + (size_t)l * 2048 * 2048, sub_keys + (size_t)l * 16 * 128 * 128, (bf16*)(ws + WS_W + (size_t)l * W_LAYER + WO_EFF), it & 511); }
        for (int i = gt; i < 4096 * 32; i += NGT) { const int pos = i >> 5, p = i & 31; const float fpos = (float)(p < 16 ? (pos >> 6) : (pos & 63));
            const float invf = exp2f(-(float)(p & 15) * (13.287712379549449f / 16.0f)); const float ang = fpos * invf;
            float rev = ang * 0.15915494309189535f; rev -= rintf(rev); ROPE[i] = make_float2(__builtin_amdgcn_cosf(rev), __builtin_amdgcn_sinf(rev)); }
    }
    SEAM(0);
    if (EN(1) && IN(1)) { PHASE_BEGIN();
        const float* x_in = INP(0); const float* ctx_in = INP(2); const float* ln_mix = INP(6); const float* ADA = WSP(float, WS_ADA); bf16* HB = WSP(bf16, WS_HB);
        for (int row_ = gw; row_ < TT; row_ += NGW) { int row = row_; asm volatile("" : "+s"(row)); const int bi = row_bi(row); const float* ap = ADA + (size_t)bi * 12288;
            norm_mod_row(row < TL ? x_in + (size_t)row * DM : ctx_in + (size_t)(row - TL) * DM, ln_mix, ap, ap + 2048, HB + (size_t)row * DM, Fp.lane); }
    }
    SEAM(1);
#pragma unroll 1
    for (int l = 0; l < NLAYER; ++l) {
        const int pb = 2 + 10 * l;
        const int MR = (l == 0) ? TT : TL;
#define LAYER_W() bf16* wl = WSP(bf16, WS_W + (size_t)l * W_LAYER); (void)wl
#define LAYER_SSQ() unsigned long long* ssq_kv = (unsigned long long*)((unsigned*)(ws + WS_CTL) + CW_SSQ) + (size_t)(2 * l) * TT; unsigned long long* ssq_q = ssq_kv + TT; (void)ssq_q
#define LAYER_ADA() const float* ada_l = WSP(float, WS_ADA) + (size_t)l * 5 * 12288
        if (EN(2) && IN(pb + 0)) { PHASE_BEGIN();
            LAYER_W(); LAYER_SSQ(); const bf16* Win_t = (const bf16*)((char*)wl + WO_IN); bf16* HB = WSP(bf16, WS_HB); bf16* P = WSP(bf16, WS_P);
            { pg8::Gemm g{HB, Win_t, MR, NINP, 2048, 2048, 2048}; pg8::StaticOrder S; S.init(MR, NINP, F.G, (int)blockIdx.x);
              pg8::EpiP E{P, NINP, ssq_kv, ssq_q};
              pg8::gemm_phase<pg8::EpiP, pg8::StaticOrder, true, true>(F.lds + RING_OFF, g, S, E); }
            { const int Mc = TT - MR; pg8::Gemm g{HB + (size_t)TL * DM, Win_t, Mc, 512, 2048, 2048, 2048}; pg8::StaticOrder S; S.init(Mc, 512, F.G, (int)blockIdx.x);
              pg8::EpiP E{P + (size_t)TL * NINP, NINP, ssq_kv + TL, ssq_q + TL};
              pg8::gemm_phase<pg8::EpiP, pg8::StaticOrder, true, true>(F.lds + RING_OFF, g, S, E); }
        }
        SEAM(pb + 0);
        if (EN(3) && IN(pb + 1)) { PHASE_BEGIN();
            LAYER_W(); LAYER_SSQ(); const bf16* Wq_t = (const bf16*)((char*)wl + WO_Q); const bf16* Wkv_t = (const bf16*)((char*)wl + WO_KV);
            bf16* P = WSP(bf16, WS_P); bf16* KN = WSP(bf16, WS_KN); bf16* VA = WSP(bf16, WS_VA); bf16* QR = WSP(bf16, WS_QR);
            { pg8::Gemm g{P, Wkv_t, TT, 4096, 256, NINP, 256}; pg8::StaticOrder S; S.init(TT, 4096, F.G, (int)blockIdx.x);
              pg8::EpiKV E{KN, VA, ssq_kv, 0};
              pg8::gemm_phase<pg8::EpiKV, pg8::StaticOrder, true, true>(F.lds + RING_OFF, g, S, E); }
            { pg8::Gemm g{P + PC_Q, Wq_t, MR, 3072, 512, NINP, 512}; pg8::StaticOrder S; S.init(MR, 3072, F.G, (int)blockIdx.x);
              pg8::EpiQ E{QR, ssq_q};
              pg8::gemm_phase<pg8::EpiQ, pg8::StaticOrder, true, true>(F.lds + RING_OFF, g, S, E); }
        }
        SEAM(pb + 1);
        if (EN(4) && IN(pb + 2)) { PHASE_BEGIN();
            const float* q_norm = INP(12); const float* k_norm = INP(13); const float* conv_w = INP(14); const float2* ROPE = WSP(float2, WS_ROPE);
            bf16* P = WSP(bf16, WS_P); bf16* KN = WSP(bf16, WS_KN); bf16* KA = WSP(bf16, WS_KA); bf16* QR = WSP(bf16, WS_QR); bf16* CV = WSP(bf16, WS_HB);
            for (int row_ = gw; row_ < TT; row_ += NGW) { int row = row_; asm volatile("" : "+s"(row)); qk_norm_row<0>(row, KN, P, KA, QR, k_norm + l * 192, ROPE, Fp.lane); }
            for (int row_ = gw; row_ < MR; row_ += NGW) { int row = row_; asm volatile("" : "+s"(row)); qk_norm_row<1>(row, KN, P, KA, QR, q_norm + l * 192, ROPE, Fp.lane); }
            for (int i = gt; i < MR * 256; i += NGT) conv_item(P, conv_w + (size_t)l * 3 * 2048, CV, i >> 8, (i & 255) * 8);
        }
        SEAM(pb + 2);
        if (EN(5) && IN(pb + 3)) { PHASE_BEGIN();
            const bf16* KA = WSP(bf16, WS_KA); const bf16* VA = WSP(bf16, WS_VA); const bf16* QR = WSP(bf16, WS_QR); bf16* ATT = WSP(bf16, WS_KN);
            const int NU = 1024 + ((l == 0) ? 64 : 0);
            for (int i = 0;; ++i) { const int u = i * F.G + F.vcu; if (u >= NU) break;
                if (u < 1024) { const int b = u >> 8, h = (u >> 4) & 15, qb = u & 15;
                    att::attn_unit(QR + (size_t)(b * SEQ + qb * 256) * 3072 + h * 192, KA + (size_t)(b * KEYS) * 3072 + h * 192, VA + (size_t)(b * KEYS) * 2048 + h * 128,
                                   ATT + (size_t)(b * SEQ + qb * 256) * 2048 + h * 128, KEYS, (char*)lds + RING_OFF); }
                else { const int uc = u - 1024, b = uc >> 4, h = uc & 15;
                    att::attn_unit(QR + (size_t)(TL + b * CTXL) * 3072 + h * 192, KA + (size_t)(b * KEYS + SEQ) * 3072 + h * 192, VA + (size_t)(b * KEYS + SEQ) * 2048 + h * 128,
                                   ATT + (size_t)(TL + b * CTXL) * 2048 + h * 128, CTXL, (char*)lds + RING_OFF); } }
        }
        SEAM(pb + 3);
        if (EN(6) && IN(pb + 4)) { PHASE_BEGIN();
            LAYER_W(); const bf16* Wa_t = (const bf16*)((char*)wl + WO_A); const bf16* Wc_t = (const bf16*)((char*)wl + WO_C);
            const bf16* P = WSP(bf16, WS_P); const bf16* ATT = WSP(bf16, WS_KN); const bf16* CV = WSP(bf16, WS_HB); bf16* Y1 = WSP(bf16, WS_KA); bf16* MB = WSP(bf16, WS_VA);
            { pg8::Gemm g{ATT, Wa_t, MR, 2048, 2048, 2048, 2048}; pg8::StaticOrder S; S.init(MR, 2048, F.G, (int)blockIdx.x);
              pg8::EpiGate<false> E{Y1, nullptr, P + PC_GA, NINP};
              pg8::gemm_phase<pg8::EpiGate<false>, pg8::StaticOrder, true, true>(F.lds + RING_OFF, g, S, E); }
            { pg8::Gemm g{CV, Wc_t, MR, 2048, 2048, 2048, 2048}; pg8::StaticOrder S; S.init(MR, 2048, F.G, (int)blockIdx.x);
              pg8::EpiGate<true> E{MB, Y1, P + PC_GB, NINP};
              pg8::gemm_phase<pg8::EpiGate<true>, pg8::StaticOrder, true, true>(F.lds + RING_OFF, g, S, E); }
        }
        SEAM(pb + 4);
        if (EN(7) && IN(pb + 5)) { PHASE_BEGIN();
            LAYER_W(); LAYER_ADA(); const bf16* Wo_t = (const bf16*)((char*)wl + WO_O); const bf16* MB = WSP(bf16, WS_VA); float* CTXB = WSP(float, WS_CTXB);
            const float* x_in = INP(0); const float* ctx_in = INP(2);
            pg8::Gemm g{MB, Wo_t, MR, 2048, 2048, 2048, 2048}; pg8::StaticOrder S; S.init(MR, 2048, F.G, (int)blockIdx.x);
            pg8::EpiRes E{l == 0 ? x_in : xout, xout, ada_l, ctx_in, CTXB};
            pg8::gemm_phase<pg8::EpiRes, pg8::StaticOrder, true, true>(F.lds + RING_OFF, g, S, E);
        }
        SEAM(pb + 5);
        if (EN(8) && IN(pb + 6)) { PHASE_BEGIN();
            LAYER_ADA(); const float* ln_ffn = INP(18); const float* u_exp = INP(21); const float* v_exp = INP(22); float* CTXB = WSP(float, WS_CTXB); bf16* HB = WSP(bf16, WS_HB);
            bf16* UB = WSP(bf16, WS_UB); bf16* VB = WSP(bf16, WS_VB);
            for (int row_ = gw; row_ < MR; row_ += NGW) { int row = row_; asm volatile("" : "+s"(row)); const int bi = row_bi(row); const float* ap = ada_l + (size_t)bi * 12288;
                norm_mod_row(row < TL ? xout + (size_t)row * DM : CTXB + (size_t)(row - TL) * DM, ln_ffn + l * DM, ap + 3 * 2048, ap + 4 * 2048, HB + (size_t)row * DM, Fp.lane); }
            const float* us = u_exp + (size_t)l * NEXP * DM; const float* vs = v_exp + (size_t)l * NEXP * DM;
            for (int i = gt; i < 2 * (NEXP * DM / 8); i += NGT) { const bool isv = i >= NEXP * DM / 8; const size_t e = (size_t)(isv ? i - NEXP * DM / 8 : i) * 8;
                const f32x4 a = *(const f32x4*)((isv ? vs : us) + e), b = *(const f32x4*)((isv ? vs : us) + e + 4);
                v4u o; o.x = pk2(a[0], a[1]); o.y = pk2(a[2], a[3]); o.z = pk2(b[0], b[1]); o.w = pk2(b[2], b[3]); *(v4u*)((isv ? VB : UB) + e) = o; }
        }
        SEAM(pb + 6);
        if (EN(9) && IN(pb + 7)) { PHASE_BEGIN();
            LAYER_W(); const bf16* Weff_t = (const bf16*)((char*)wl + WO_EFF); const bf16* HB = WSP(bf16, WS_HB); float* SC = WSP(float, WS_P);
            pg8::Gemm g{HB, Weff_t, MR, 2048, 2048, 2048, 2048}; pg8::StaticOrder S; S.init(MR, 2048, F.G, (int)blockIdx.x);
            pg8::EpiF32 E{SC, 2048};
            pg8::gemm_phase<pg8::EpiF32, pg8::StaticOrder, true, true>(F.lds + RING_OFF, g, S, E);
        }
        SEAM(pb + 7);
        if (EN(10) && IN(pb + 8)) { PHASE_BEGIN();
            const float* SC = WSP(float, WS_P); int* IDX = WSP(int, WS_IDX); float* GW = WSP(float, WS_GW);
            LAS int* lists = (LAS int*)(F.lds + RING_OFF + F.wave * 8192);
            for (int it_ = gw; it_ < MR / 8; it_ += NGW) { int it = it_; asm volatile("" : "+s"(it)); topk_item(SC, IDX, GW, it * 8, lists, Fp.lane); }
        }
        SEAM(pb + 8);
        if (EN(11) && IN(pb + 9)) { PHASE_BEGIN();
            LAYER_ADA(); const float* ln_mix = INP(6); const float* ADA = WSP(float, WS_ADA); float* CTXB = WSP(float, WS_CTXB); bf16* HB = WSP(bf16, WS_HB);
            const int* IDX = WSP(int, WS_IDX); const float* GW = WSP(float, WS_GW); const bf16* UB = WSP(bf16, WS_UB); const bf16* VB = WSP(bf16, WS_VB);
            for (int row_ = gw; row_ < MR; row_ += NGW) { int row = row_; asm volatile("" : "+s"(row));
                float o[32];
                peer_row(HB + (size_t)row * DM, IDX + (size_t)row * 128, GW + (size_t)row * 128, UB, VB, o, Fp.lane);
                const int bi = row_bi(row); const float* g2 = ada_l + (size_t)bi * 12288 + 5 * 2048;
                float* xr = (row < TL) ? xout + (size_t)row * DM : CTXB + (size_t)(row - TL) * DM;
                float s = 0.f; const unsigned l32 = (unsigned)Fp.lane * 32u, l16 = (unsigned)Fp.lane * 16u;
#pragma unroll
                for (int j = 0; j < 4; ++j) {
                    const f32x4 a = ldu<f32x4>(xr, l32 + j * 2048), b = ldu<f32x4>(xr, l32 + j * 2048 + 16), ga = ldu<f32x4>(g2, l32 + j * 2048), gb = ldu<f32x4>(g2, l32 + j * 2048 + 16);
                    f32x4 na, nb;
#pragma unroll
                    for (int c = 0; c < 4; ++c) { na[c] = a[c] + ga[c] * o[8 * j + c]; nb[c] = b[c] + gb[c] * o[8 * j + 4 + c]; o[8 * j + c] = na[c]; o[8 * j + 4 + c] = nb[c]; s += na[c] * na[c] + nb[c] * nb[c]; }
                    stu<f32x4>(xr, l32 + j * 2048, na); stu<f32x4>(xr, l32 + j * 2048 + 16, nb); }
                if (l + 1 < NLAYER) {
                    const float r = __builtin_amdgcn_rsqf(wave_sum(s) * (1.0f / 2048.0f) + pg8::RMS_EPS);
                    const float* gain = ln_mix + (l + 1) * DM; const float* ap = ADA + ((size_t)(l + 1) * 5 + bi) * 12288;
#pragma unroll
                    for (int j = 0; j < 4; ++j) {
                        const f32x4 g0 = ldu<f32x4>(gain, l32 + j * 2048), g1 = ldu<f32x4>(gain, l32 + j * 2048 + 16), s0 = ldu<f32x4>(ap + 2048, l32 + j * 2048), s1 = ldu<f32x4>(ap + 2048, l32 + j * 2048 + 16),
                                    h0 = ldu<f32x4>(ap, l32 + j * 2048), h1 = ldu<f32x4>(ap, l32 + j * 2048 + 16);
                        float y[8];
#pragma unroll
                        for (int c = 0; c < 4; ++c) { y[c] = (o[8 * j + c] * r * g0[c]) * (s0[c] + 1.0f) + h0[c]; y[4 + c] = (o[8 * j + 4 + c] * r * g1[c]) * (s1[c] + 1.0f) + h1[c]; }
                        v4u w; w.x = pk2(y[0], y[1]); w.y = pk2(y[2], y[3]); w.z = pk2(y[4], y[5]); w.w = pk2(y[6], y[7]); stu<v4u>(HB + (size_t)row * DM, l16 + j * 1024, w); }
                }
            }
        }
        SEAM(pb + 9);
    }
#undef IN
#undef SEAM
}

#ifndef MK_N_LAUNCHES
#define MK_N_LAUNCHES 1
#endif
extern "C" void kernel_launch(void* const* d_in, const int* in_sizes, int n_in, void* d_out, int out_size, void* d_ws, size_t ws_size, hipStream_t stream) {
    static int grid = 0;
    if (grid == 0) {
        if (n_in != 23 || out_size != TL * DM || ws_size < WS_END) { fprintf(stderr, "kernel_launch: shape/workspace mismatch (n_in %d out %d ws %zu need %zu)\n", n_in, out_size, ws_size, (size_t)WS_END); grid = -1; return; }
        int dev = 0, cus = 0;
        if (hipGetDevice(&dev) != hipSuccess || hipDeviceGetAttribute(&cus, hipDeviceAttributeMultiprocessorCount, dev) != hipSuccess) { grid = -1; return; }
        if (hipFuncSetAttribute((const void*)fwd_kernel, hipFuncAttributeMaxDynamicSharedMemorySize, LDS_BYTES) != hipSuccess) { fprintf(stderr, "kernel_launch: hipFuncSetAttribute failed\n"); grid = -1; return; }
        int per_cu = 0;
        if (hipOccupancyMaxActiveBlocksPerMultiprocessor(&per_cu, (const void*)fwd_kernel, NWAVES * 64, LDS_BYTES) != hipSuccess || per_cu < 1) { fprintf(stderr, "kernel_launch: occupancy query reports %d\n", per_cu); (void)hipGetLastError(); }
        grid = cus;
    }
    if (grid < 0) return;
    if (hipMemsetAsync((char*)d_ws + WS_CTL, 0, CTL_ZERO_BYTES, stream) != hipSuccess) return;
    Args a{};
    for (int i = 0; i < 23; ++i) a.in[i] = (const float*)d_in[i];
    a.out = (float*)d_out; a.ws = (unsigned char*)d_ws;
#if MK_N_LAUNCHES == 1
    a.ph_lo = 0; a.ph_hi = NPHASE; a.li = 0;
    hipLaunchKernelGGL(fwd_kernel, dim3(grid), dim3(NWAVES * 64), LDS_BYTES, stream, a);
#else
    for (int p = 0; p < NPHASE; ++p) { a.ph_lo = p; a.ph_hi = p + 1; a.li = p; hipLaunchKernelGGL(fwd_kernel, dim3(grid), dim3(NWAVES * 64), LDS_BYTES, stream, a); }
#endif
}
```

```cpp
#include <hip/hip_runtime.h>
#include <cstdio>
#include <cstdint>
namespace pg8 {
#define PG8_LAS __attribute__((address_space(3)))
typedef unsigned short bf16_t;
typedef short bf16x8 __attribute__((ext_vector_type(8)));
typedef float f32x4 __attribute__((ext_vector_type(4)));
typedef unsigned u32x4 __attribute__((ext_vector_type(4)));
constexpr int BM = 256, BK = 64, HALF = 128, HTB = HALF * BK * 2  , STAGE_BYTES = 8 * HTB, NXCD = 8, WGM = 8;

__host__ __device__ __forceinline__ int lds_byte(int r, int c) { const int st = (r >> 4) * 2 + (c >> 5), rr = r & 15, cc = c & 31, ob = rr * 64 + cc * 2; return st * 1024 + (ob ^ (((ob >> 9) & 1) << 5)); }
__host__ __device__ __forceinline__ void stage_rc(int b, int& R, int& C) { const int st = b / 1024, sb = b % 1024, swz = sb ^ (((sb >> 9) & 1) << 5); R = (st >> 1) * 16 + swz / 64; C = (st & 1) * 32 + (swz % 64) / 2; }
__host__ __device__ __forceinline__ int perm32(int rho) { const int n = rho >> 4, i = rho & 15; return 8 * (i >> 2) + 4 * n + (i & 3); }

struct Unit { int pm, pn; };
struct Gemm { const bf16_t* A; const bf16_t* Bt; int M, N, K, lda, ldb; };

struct StaticOrder {
    int nM, nN, nwg, G, c;
    __host__ __device__ void init(int M, int N, int G_, int c_) { nM = M / BM; nN = N / BM; nwg = nM * nN; G = G_; c = c_; }
    __host__ __device__ bool next(int i, Unit& u) const {
        const long L = (long)i * G + c; if (L >= nwg) return false;
        int wgid = (int)L; { const int q = nwg / NXCD, r = nwg % NXCD, xcd = wgid % NXCD, off = wgid / NXCD; wgid = (xcd < r ? xcd * (q + 1) : r * (q + 1) + (xcd - r) * q) + off; }
        const int nig = WGM * nN, gid = wgid / nig, fm = gid * WGM, gsz = (nM - fm) < WGM ? (nM - fm) : WGM;
        u.pm = fm + ((wgid % nig) % gsz); u.pn = (wgid % nig) / gsz; return true;
    }
    __device__ __forceinline__ void a_ready(const Unit&) const {}
    __device__ __forceinline__ void done(const Unit&) const {}
};

__device__ __forceinline__ unsigned cvt_pk_bf16(float lo, float hi) { unsigned r; asm volatile("v_cvt_pk_bf16_f32 %0, %1, %2" : "=v"(r) : "v"(lo), "v"(hi)); return r; }
__device__ __forceinline__ float bf_lo(unsigned w) { return __uint_as_float(w << 16); }
__device__ __forceinline__ float bf_hi(unsigned w) { return __uint_as_float(w & 0xffff0000u); }
__device__ __forceinline__ float sigmoidf_(float x) { return __builtin_amdgcn_rcpf(1.0f + __expf(-x)); }
__device__ __forceinline__ u32x4 pack8(const f32x4 v0, const f32x4 v1) { u32x4 w; w.x = cvt_pk_bf16(v0[0], v0[1]); w.y = cvt_pk_bf16(v0[2], v0[3]); w.z = cvt_pk_bf16(v1[0], v1[1]); w.w = cvt_pk_bf16(v1[2], v1[3]); return w; }
constexpr float RMS_EPS = 1e-6f;

struct EpiP {
    static constexpr bool PERM = true, AFTER_DRAIN = false;
    bf16_t* O; int ldc; unsigned long long* ssq_kv; unsigned long long* ssq_q;
    __device__ __forceinline__ void operator()(const f32x4 (&acc)[2][2][4][2], const Unit& u, int wr, int wc, int fr, int fq) const {
        const int row0 = u.pm * BM + wr * 64 + fr, col0 = u.pn * BM + wc * 32 + 8 * fq;
        unsigned long long* ssq = (u.pn == 0) ? ssq_kv : ((u.pn == 2 || u.pn == 3) ? ssq_q : nullptr);
#pragma unroll
        for (int ai = 0; ai < 2; ++ai)
#pragma unroll
            for (int m = 0; m < 4; ++m) { const int row = row0 + ai * HALF + m * 16; bf16_t* rowp = O + (size_t)row * ldc + col0; float s = 0.f;
#pragma unroll
                for (int bj = 0; bj < 2; ++bj) { const f32x4 v0 = acc[ai][bj][m][0], v1 = acc[ai][bj][m][1];
                    s += (v0[0] * v0[0] + v0[1] * v0[1]) + (v0[2] * v0[2] + v0[3] * v0[3]) + (v1[0] * v1[0] + v1[1] * v1[1]) + (v1[2] * v1[2] + v1[3] * v1[3]);
                    *(u32x4*)(rowp + bj * HALF) = pack8(v0, v1); }
                if (ssq) { s += __shfl_xor(s, 16); s += __shfl_xor(s, 32); if (fq == 0) atomicAdd(ssq + row, (unsigned long long)(s * 1048576.0f)); } }
    }
};
__device__ __forceinline__ int key_row(int row) { return row < 16384 ? (row >> 12) * 4352 + (row & 4095) : ((row - 16384) >> 8) * 4352 + 4096 + ((row - 16384) & 255); }
struct EpiKV {
    static constexpr bool PERM = true, AFTER_DRAIN = false;
    bf16_t* KN; bf16_t* VA; const unsigned long long* ssq; int row_off;
    __device__ __forceinline__ void operator()(const f32x4 (&acc)[2][2][4][2], const Unit& u, int wr, int wc, int fr, int fq) const {
        const bool isv = u.pn >= 8;
        const int delta = u.pm < 64 ? (u.pm >> 4) * 256 : (u.pm - 64) * 4096 - 12288;
        char* base = isv ? (char*)(VA + (size_t)delta * 2048) : (char*)KN;
        const int rl = wr * 64 + fr;
        const unsigned off0 = ((unsigned)(u.pm * BM + rl) * 2048u + (unsigned)((u.pn & 7) * BM + wc * 32 + 8 * fq)) * 2u;
        const unsigned long long* sp = ssq + u.pm * BM;
#pragma unroll
        for (int ai = 0; ai < 2; ++ai)
#pragma unroll
            for (int m = 0; m < 4; ++m) { const float r = __builtin_amdgcn_rsqf((float)*(const unsigned long long*)((const char*)sp + (unsigned)(rl + ai * HALF + m * 16) * 8u) * (1.0f / (256.0f * 1048576.0f)) + RMS_EPS);
#pragma unroll
                for (int bj = 0; bj < 2; ++bj) *(u32x4*)(base + (off0 + (unsigned)((ai * HALF + m * 16) * 2048 + bj * HALF) * 2u)) = pack8(acc[ai][bj][m][0] * r, acc[ai][bj][m][1] * r); }
    }
};
struct EpiQ {
    static constexpr bool PERM = true, AFTER_DRAIN = false;
    bf16_t* QR; const unsigned long long* ssq;
    __device__ __forceinline__ void operator()(const f32x4 (&acc)[2][2][4][2], const Unit& u, int wr, int wc, int fr, int fq) const {
        const int rl = wr * 64 + fr;
        const unsigned off0 = ((unsigned)(u.pm * BM + rl) * 3072u + (unsigned)(u.pn * BM + wc * 32 + 8 * fq)) * 2u;
        const unsigned long long* sp = ssq + u.pm * BM;
#pragma unroll
        for (int ai = 0; ai < 2; ++ai)
#pragma unroll
            for (int m = 0; m < 4; ++m) { const float r = __builtin_amdgcn_rsqf((float)*(const unsigned long long*)((const char*)sp + (unsigned)(rl + ai * HALF + m * 16) * 8u) * (1.0f / (512.0f * 1048576.0f)) + RMS_EPS);
#pragma unroll
                for (int bj = 0; bj < 2; ++bj) *(u32x4*)((char*)QR + (off0 + (unsigned)((ai * HALF + m * 16) * 3072 + bj * HALF) * 2u)) = pack8(acc[ai][bj][m][0] * r, acc[ai][bj][m][1] * r); }
    }
};
template <bool ADD> struct EpiGate {
    static constexpr bool PERM = true, AFTER_DRAIN = false;
    bf16_t* Y; const bf16_t* Yin; const bf16_t* G; int ldg;
    __device__ __forceinline__ void operator()(const f32x4 (&acc)[2][2][4][2], const Unit& u, int wr, int wc, int fr, int fq) const {
        const int row0 = u.pm * BM + wr * 64 + fr, col0 = u.pn * BM + wc * 32 + 8 * fq;
#pragma unroll
        for (int ai = 0; ai < 2; ++ai)
#pragma unroll
            for (int m = 0; m < 4; ++m) { const int row = row0 + ai * HALF + m * 16;
#pragma unroll
                for (int bj = 0; bj < 2; ++bj) { const int col = col0 + bj * HALF;
                    const u32x4 g = *(const u32x4*)(G + (size_t)row * ldg + col); f32x4 v0 = acc[ai][bj][m][0], v1 = acc[ai][bj][m][1];
                    v0[0] *= sigmoidf_(bf_lo(g.x)); v0[1] *= sigmoidf_(bf_hi(g.x)); v0[2] *= sigmoidf_(bf_lo(g.y)); v0[3] *= sigmoidf_(bf_hi(g.y));
                    v1[0] *= sigmoidf_(bf_lo(g.z)); v1[1] *= sigmoidf_(bf_hi(g.z)); v1[2] *= sigmoidf_(bf_lo(g.w)); v1[3] *= sigmoidf_(bf_hi(g.w));
                    if (ADD) { const u32x4 y = *(const u32x4*)(Yin + (size_t)row * 2048 + col);
                        v0[0] += bf_lo(y.x); v0[1] += bf_hi(y.x); v0[2] += bf_lo(y.y); v0[3] += bf_hi(y.y); v1[0] += bf_lo(y.z); v1[1] += bf_hi(y.z); v1[2] += bf_lo(y.w); v1[3] += bf_hi(y.w); }
                    *(u32x4*)(Y + (size_t)row * 2048 + col) = pack8(v0, v1); } }
    }
};
struct EpiRes {
    static constexpr bool PERM = false, AFTER_DRAIN = false;
    const float* base; float* out; const float* gates;
    const float* cbase; float* cout;
    __device__ __forceinline__ void operator()(const f32x4 (&acc)[2][2][4][2], const Unit& u, int wr, int wc, int fr, int fq) const {
        const bool isc = u.pm >= 64; const int bi = isc ? 4 : (u.pm >> 4);
        const float* gp = gates + (size_t)bi * (6 * 2048) + 2 * 2048; const float* bp = isc ? cbase : base; float* op = isc ? cout : out;
        const int row0 = (isc ? (u.pm - 64) : u.pm) * BM + wr * 64 + fr, col0 = u.pn * BM + wc * 32 + 4 * fq;
        f32x4 gv[2][2];
#pragma unroll
        for (int bj = 0; bj < 2; ++bj)
#pragma unroll
            for (int n = 0; n < 2; ++n) gv[bj][n] = *(const f32x4*)(gp + col0 + bj * HALF + n * 16);
#pragma unroll
        for (int ai = 0; ai < 2; ++ai)
#pragma unroll
            for (int m = 0; m < 4; ++m) { const size_t off = (size_t)(row0 + ai * HALF + m * 16) * 2048 + col0;
#pragma unroll
                for (int bj = 0; bj < 2; ++bj)
#pragma unroll
                    for (int n = 0; n < 2; ++n) { const f32x4 b = *(const f32x4*)(bp + off + bj * HALF + n * 16); *(f32x4*)(op + off + bj * HALF + n * 16) = b + gv[bj][n] * acc[ai][bj][m][n]; } }
    }
};
struct EpiF32 {
    static constexpr bool PERM = false, AFTER_DRAIN = false;
    float* C; int ldc;
    __device__ __forceinline__ void operator()(const f32x4 (&acc)[2][2][4][2], const Unit& u, int wr, int wc, int fr, int fq) const {
        const int row0 = u.pm * BM + wr * 64 + fr, col0 = u.pn * BM + wc * 32 + 4 * fq;
#pragma unroll
        for (int ai = 0; ai < 2; ++ai)
#pragma unroll
            for (int m = 0; m < 4; ++m) { float* rowp = C + (size_t)(row0 + ai * HALF + m * 16) * ldc + col0;
#pragma unroll
                for (int bj = 0; bj < 2; ++bj)
#pragma unroll
                    for (int n = 0; n < 2; ++n) *(f32x4*)(rowp + bj * HALF + n * 16) = acc[ai][bj][m][n]; }
    }
};

template <class Epi, class Sched, bool ALIGN_EPI = false, bool SP2 = false>
__device__ __forceinline__ void gemm_phase(PG8_LAS unsigned char* lds, const Gemm g, const Sched& S, const Epi& E) {
    int tid_o = threadIdx.x; asm volatile("" : "+v"(tid_o));
    const int tid = tid_o, wid = __builtin_amdgcn_readfirstlane(tid >> 6), lane = tid & 63, wr = wid >> 2, wc = wid & 3, fr = lane & 15, fq = lane >> 4;
    int K_o = g.K; asm volatile("" : "+s"(K_o));
    const int K = K_o, nt = K / BK;
    unsigned voffA[2], voffB[2];
#pragma unroll
    for (int i = 0; i < 2; ++i) { int R, C; stage_rc(tid * 16 + i * 8192, R, C); const int Rb = Epi::PERM ? ((R & ~31) + perm32(R & 31)) : R;
        voffA[i] = (unsigned)(R * g.lda + C) * 2u; voffB[i] = (unsigned)(Rb * g.ldb + C) * 2u; }
    const size_t kstep = (size_t)(BK * 2);
    const size_t hstepA = (size_t)HALF * g.lda * 2, hstepB = (size_t)HALF * g.ldb * 2;
    const size_t tstepA = 2 * hstepA, tstepB = 2 * hstepB;
    const unsigned ldsw = (unsigned)wid * 1024u;
    const int aoff = lds_byte(wr * 64 + fr, fq * 8), boff = lds_byte(wc * 32 + fr, fq * 8);
#define PG8_SA(b, h) (((b) * 2 + (h)) * HTB)
#define PG8_SB(b, h) ((4 + (b) * 2 + (h)) * HTB)
#define PG8_STAGE(bufoff, gbase, voff) do { _Pragma("unroll") for (int _i = 0; _i < 2; ++_i) \
        __builtin_amdgcn_global_load_lds((const unsigned*)((const char*)(gbase) + (voff)[_i]), (PG8_LAS unsigned*)(lds + (bufoff) + ldsw + _i * 8192), 16, 0, 0); } while (0)
#define PG8_LDA(dst, b, h) do { _Pragma("unroll") for (int m = 0; m < 4; ++m) _Pragma("unroll") for (int k = 0; k < 2; ++k) dst[m][k] = *(const PG8_LAS bf16x8*)(lds + PG8_SA(b, h) + aoff + m * 2048 + k * 1024); } while (0)
#define PG8_LDB(dst, b, h) do { _Pragma("unroll") for (int n = 0; n < 2; ++n) _Pragma("unroll") for (int k = 0; k < 2; ++k) dst[n][k] = *(const PG8_LAS bf16x8*)(lds + PG8_SB(b, h) + boff + n * 2048 + k * 1024); } while (0)
#define PG8_MMA(ai, bj, At, Bt) do { __builtin_amdgcn_s_setprio(1); _Pragma("unroll") for (int m = 0; m < 4; ++m) _Pragma("unroll") for (int n = 0; n < 2; ++n) _Pragma("unroll") for (int k = 0; k < 2; ++k) \
        acc[ai][bj][m][n] = __builtin_amdgcn_mfma_f32_16x16x32_bf16(Bt[n][k], At[m][k], acc[ai][bj][m][n], 0, 0, 0); __builtin_amdgcn_s_setprio(0); } while (0)
#define PG8_WAIT_V(n) asm volatile("s_waitcnt vmcnt(" #n ")" ::: "memory")
#define PG8_WAIT_L(n) asm volatile("s_waitcnt lgkmcnt(" #n ")" ::: "memory")
#define PG8_BAR __builtin_amdgcn_s_barrier()
#define PG8_SCHED __builtin_amdgcn_sched_barrier(0)
    Unit cur, nxt; int ui = 0;
    if (!S.next(0, cur)) return;
    f32x4 acc[2][2][4][2];
#pragma unroll
    for (int a = 0; a < 2; ++a)
#pragma unroll
        for (int b = 0; b < 2; ++b)
#pragma unroll
            for (int m = 0; m < 4; ++m)
#pragma unroll
                for (int n = 0; n < 2; ++n) acc[a][b][m][n] = (f32x4){0.f, 0.f, 0.f, 0.f};
    bf16x8 At[4][2], B0[2][2], B1[2][2];
    const char* cA = (const char*)g.A + (size_t)cur.pm * tstepA; const char* cB = (const char*)g.Bt + (size_t)cur.pn * tstepB;
    S.a_ready(cur);
    if constexpr (SP2) {
        PG8_STAGE(PG8_SB(0, 0), cB, voffB); PG8_STAGE(PG8_SB(0, 1), cB + hstepB, voffB); PG8_STAGE(PG8_SA(0, 0), cA, voffA); PG8_STAGE(PG8_SA(0, 1), cA + hstepA, voffA);
        if (wr == 1) PG8_BAR;
        PG8_WAIT_V(2); PG8_BAR;
        PG8_STAGE(PG8_SB(1, 0), cB + kstep, voffB); PG8_STAGE(PG8_SA(1, 0), cA + kstep, voffA); PG8_STAGE(PG8_SB(1, 1), cB + hstepB + kstep, voffB);
        PG8_WAIT_V(6); PG8_BAR;
    } else {
        PG8_STAGE(PG8_SB(0, 0), cB, voffB); PG8_STAGE(PG8_SA(0, 0), cA, voffA); PG8_STAGE(PG8_SB(0, 1), cB + hstepB, voffB); PG8_STAGE(PG8_SA(0, 1), cA + hstepA, voffA);
        if (wr == 1) PG8_BAR;
        PG8_WAIT_V(4); PG8_BAR;
        PG8_STAGE(PG8_SB(1, 0), cB + kstep, voffB); PG8_STAGE(PG8_SA(1, 0), cA + kstep, voffA); PG8_STAGE(PG8_SB(1, 1), cB + hstepB + kstep, voffB);
        PG8_WAIT_V(6); PG8_BAR;
    }
    for (;;) {
        const bool has_next = S.next(ui + 1, nxt);
        const char* nA = has_next ? (const char*)g.A + (size_t)nxt.pm * tstepA : cA; const char* nB = has_next ? (const char*)g.Bt + (size_t)nxt.pn * tstepB : cB;
        for (int t = 0; t < nt; t += 2) {
            const bool last = (t == nt - 2);
            const char* a1 = cA + (size_t)(t + 1) * kstep;
            const char* a2 = last ? nA : cA + (size_t)(t + 2) * kstep; const char* b2 = last ? nB : cB + (size_t)(t + 2) * kstep;
            const char* a3 = a2 + kstep; const char* b3 = b2 + kstep;
            if (last && has_next) S.a_ready(nxt);
            if constexpr (SP2) {
            PG8_LDB(B0, 0, 0); PG8_LDB(B1, 0, 1); PG8_SCHED; PG8_LDA(At, 0, 0); PG8_STAGE(PG8_SA(1, 1), a1 + hstepA, voffA);
            PG8_WAIT_V(8); PG8_WAIT_L(0); PG8_BAR; PG8_MMA(0, 0, At, B0); PG8_MMA(0, 1, At, B1); PG8_BAR; PG8_SCHED;
            PG8_LDA(At, 0, 1); PG8_STAGE(PG8_SB(0, 0), b2, voffB); PG8_STAGE(PG8_SB(0, 1), b2 + hstepB, voffB); PG8_STAGE(PG8_SA(0, 0), a2, voffA);
            PG8_WAIT_V(8); PG8_WAIT_L(0); PG8_BAR; PG8_MMA(1, 0, At, B0); PG8_MMA(1, 1, At, B1); PG8_BAR; PG8_SCHED;
            PG8_LDB(B0, 1, 0); PG8_LDB(B1, 1, 1); PG8_SCHED; PG8_LDA(At, 1, 0); PG8_STAGE(PG8_SA(0, 1), a2 + hstepA, voffA);
            PG8_WAIT_V(8); PG8_WAIT_L(0); PG8_BAR; PG8_MMA(0, 0, At, B0); PG8_MMA(0, 1, At, B1); PG8_BAR; PG8_SCHED;
            PG8_LDA(At, 1, 1); PG8_STAGE(PG8_SB(1, 0), b3, voffB); PG8_STAGE(PG8_SB(1, 1), b3 + hstepB, voffB); PG8_STAGE(PG8_SA(1, 0), a3, voffA);
            PG8_WAIT_V(8); PG8_WAIT_L(0); PG8_BAR; PG8_MMA(1, 0, At, B0); PG8_MMA(1, 1, At, B1); PG8_BAR; PG8_SCHED;
            } else {
            PG8_LDB(B0, 0, 0); PG8_SCHED; PG8_LDA(At, 0, 0); PG8_STAGE(PG8_SA(1, 1), a1 + hstepA, voffA);
            PG8_WAIT_L(8); PG8_BAR; PG8_WAIT_L(0); PG8_MMA(0, 0, At, B0); PG8_BAR; PG8_SCHED;
            PG8_LDB(B1, 0, 1); PG8_STAGE(PG8_SB(0, 0), b2, voffB);
            PG8_BAR; PG8_WAIT_L(0); PG8_MMA(0, 1, At, B1); PG8_BAR;
            PG8_LDA(At, 0, 1); PG8_STAGE(PG8_SA(0, 0), a2, voffA);
            PG8_BAR; PG8_WAIT_L(0); PG8_MMA(1, 0, At, B0); PG8_BAR; PG8_SCHED;
            PG8_STAGE(PG8_SB(0, 1), b2 + hstepB, voffB);
            PG8_WAIT_V(6); PG8_BAR; PG8_MMA(1, 1, At, B1); PG8_BAR;
            PG8_LDB(B0, 1, 0); PG8_SCHED; PG8_LDA(At, 1, 0); PG8_STAGE(PG8_SA(0, 1), a2 + hstepA, voffA);
            PG8_WAIT_L(8); PG8_BAR; PG8_WAIT_L(0); PG8_MMA(0, 0, At, B0); PG8_BAR; PG8_SCHED;
            PG8_LDB(B1, 1, 1); PG8_STAGE(PG8_SB(1, 0), b3, voffB);
            PG8_BAR; PG8_WAIT_L(0); PG8_MMA(0, 1, At, B1); PG8_BAR;
            PG8_LDA(At, 1, 1); PG8_STAGE(PG8_SA(1, 0), a3, voffA);
            PG8_BAR; PG8_WAIT_L(0); PG8_MMA(1, 0, At, B0); PG8_BAR; PG8_SCHED;
            PG8_STAGE(PG8_SB(1, 1), b3 + hstepB, voffB);
            PG8_WAIT_V(6); PG8_BAR; PG8_MMA(1, 1, At, B1); PG8_BAR;
            }
        }
        if constexpr (ALIGN_EPI) { if (wr == 0) PG8_BAR; }
        if constexpr (!Epi::AFTER_DRAIN) { E(acc, cur, wr, wc, fr, fq); S.done(cur); }
        if (!has_next) break;
#pragma unroll
        for (int a = 0; a < 2; ++a)
#pragma unroll
            for (int b = 0; b < 2; ++b)
#pragma unroll
                for (int m = 0; m < 4; ++m)
#pragma unroll
                    for (int n = 0; n < 2; ++n) acc[a][b][m][n] = (f32x4){0.f, 0.f, 0.f, 0.f};
        cur = nxt; cA = nA; cB = nB; ++ui;
        if constexpr (ALIGN_EPI) { if (wr == 1) PG8_BAR; }
    }
    PG8_WAIT_V(0);
    if constexpr (!ALIGN_EPI) { if (wr == 0) PG8_BAR; }
    PG8_BAR;
    if constexpr (Epi::AFTER_DRAIN) { E.fused(acc, cur, wr, wc, fr, fq, lds, wid, lane); S.done(cur); }
#undef PG8_SA
#undef PG8_SB
#undef PG8_STAGE
#undef PG8_LDA
#undef PG8_LDB
#undef PG8_MMA
#undef PG8_WAIT_V
#undef PG8_WAIT_L
#undef PG8_BAR
#undef PG8_SCHED
}
}
namespace att {
using bf16x8 = __attribute__((ext_vector_type(8))) short;
using s16x4  = __attribute__((ext_vector_type(4))) short;
using f32x16 = __attribute__((ext_vector_type(16))) float;
using u32x4  = __attribute__((ext_vector_type(4))) unsigned;
typedef unsigned short bf16_t;
constexpr int DQK = 192, DV = 128, NW = 8, QBLK = 32, KVBLK = 64, ND0 = DQK / 16;
constexpr float SCALE = 0.07216878364870322f;
constexpr float THR = 8.f;
constexpr int LDQ = 3072, LDK = 3072, LDV = 2048, LDO = 2048;
constexpr int SHM_V = KVBLK * DV * 2, SHM_K = KVBLK * DQK * 2, SHM_WS = 2 * SHM_V + 2 * SHM_K, SHM_QR = SHM_WS + NW * 64 * 4, SHM_ATTN = SHM_QR + NW * 4096;
#define ATT_KSWZ(row, colB) ((row) * 384 + ((colB) ^ (((row) & 7) << 4)))
#define ATT_SBAR() __builtin_amdgcn_sched_barrier(0)
__device__ __forceinline__ int crow(int r, int hi) { return (r & 3) + 8 * (r >> 2) + 4 * hi; }
__device__ __forceinline__ unsigned cvtpk(float lo, float hi) { unsigned r; asm volatile("v_cvt_pk_bf16_f32 %0, %1, %2" : "=v"(r) : "v"(lo), "v"(hi)); return r; }
__device__ __forceinline__ void partialSM(f32x16& p0, f32x16& p1, float& m_reg, float& mn, float& alpha) {
  constexpr float C = SCALE * 1.4426950408889634f;
  float pmax = p0[0];
#pragma unroll
  for (int r = 1; r < 16; ++r) pmax = fmaxf(pmax, p0[r]);
#pragma unroll
  for (int r = 0; r < 16; ++r) pmax = fmaxf(pmax, p1[r]);
  { auto rr = __builtin_amdgcn_permlane32_swap(__float_as_uint(pmax), __float_as_uint(pmax), false, false);
    pmax = fmaxf(__uint_as_float(rr[0]), __uint_as_float(rr[1])); }
  if (__builtin_expect(__all(pmax - m_reg <= THR / SCALE), 1)) { mn = m_reg; alpha = 1.f; }
  else { mn = fmaxf(m_reg, pmax); alpha = __builtin_amdgcn_exp2f((m_reg - mn) * C); m_reg = mn; }
  float mnC = -mn * C;
#pragma unroll
  for (int r = 0; r < 16; ++r) p0[r] = fmaf(p0[r], C, mnC);
#pragma unroll
  for (int r = 0; r < 16; ++r) p1[r] = fmaf(p1[r], C, mnC);
#pragma unroll
  for (int r = 0; r < 16; ++r) p0[r] = __builtin_amdgcn_exp2f(p0[r]);
}
__device__ __forceinline__ void finishSM(f32x16& p0, f32x16& p1, float alpha, float& l_reg, bf16x8& pa0, bf16x8& pa1, bf16x8& pa2, bf16x8& pa3) {
#pragma unroll
  for (int r = 0; r < 16; ++r) p1[r] = __builtin_amdgcn_exp2f(p1[r]);
  float ps = 0;
#pragma unroll
  for (int r = 0; r < 16; ++r) ps += p0[r];
#pragma unroll
  for (int r = 0; r < 16; ++r) ps += p1[r];
  { auto rr = __builtin_amdgcn_permlane32_swap(__float_as_uint(ps), __float_as_uint(ps), false, false);
    ps = __uint_as_float(rr[0]) + __uint_as_float(rr[1]); }
  l_reg = l_reg * alpha + ps;
#define ATT_PK4(P, BASE, OUT) do { unsigned a0 = cvtpk(P[BASE + 0], P[BASE + 1]), a1 = cvtpk(P[BASE + 2], P[BASE + 3]);   \
    unsigned b0 = cvtpk(P[BASE + 4], P[BASE + 5]), b1 = cvtpk(P[BASE + 6], P[BASE + 7]);                              \
    auto r0 = __builtin_amdgcn_permlane32_swap(a0, b0, false, false); auto r1 = __builtin_amdgcn_permlane32_swap(a1, b1, false, false); \
    u32x4 w = {r0[0], r1[0], r0[1], r1[1]}; OUT = *reinterpret_cast<bf16x8*>(&w); } while (0)
  ATT_PK4(p0, 0, pa0); ATT_PK4(p0, 8, pa1); ATT_PK4(p1, 0, pa2); ATT_PK4(p1, 8, pa3);
#undef ATT_PK4
}
__device__ __forceinline__ void qkt(f32x16& p0, f32x16& p1, const char* Ks, const bf16x8* qr, const char* qrl, int r32, int hi) {
  p0 = f32x16{}; p1 = f32x16{};
#pragma unroll
  for (int d0 = 0; d0 < ND0; ++d0) { const int cb = (d0 * 16 + hi * 8) * 2;
    bf16x8 b0 = *reinterpret_cast<const bf16x8*>(Ks + ATT_KSWZ(r32, cb));
    bf16x8 b1 = *reinterpret_cast<const bf16x8*>(Ks + ATT_KSWZ(32 + r32, cb));
    const bf16x8 q = (d0 < 8) ? qr[d0 < 8 ? d0 : 0] : *reinterpret_cast<const bf16x8*>(qrl + (d0 - 8) * 1024);
    p0 = __builtin_amdgcn_mfma_f32_32x32x16_bf16(b0, q, p0, 0, 0, 0);
    p1 = __builtin_amdgcn_mfma_f32_32x32x16_bf16(b1, q, p1, 0, 0, 0); }
}
__device__ __forceinline__ int v_st(int k, int c) { const int kk = (k & ~0xC) | ((k & 4) << 1) | ((k & 8) >> 1); return ((kk >> 3) * 4 + (c >> 5)) * 512 + ((kk & 7) * 32 + (c & 31)) * 2; }
__device__ __forceinline__ int v_rd_base(int lane) { return ((lane & 3) << 3) | (((lane >> 2) & 3) << 6) | (((lane >> 4) & 1) << 5) | (((lane >> 5) & 1) << 8); }
constexpr int v_rd_off(int d0, int ks, int half) { return d0 * 512 + ks * 4096 + half * 2048; }
template <int OFF> __device__ __forceinline__ s16x4 tr_read(int vb) {
  s16x4 r; asm volatile("ds_read_b64_tr_b16 %0, %1 offset:%2" : "=&v"(r) : "v"(vb), "i"(OFF) : "memory"); return r;
}
template <int D0> __device__ __forceinline__ void pv_one(f32x16& od, int vb, bf16x8 pa0, bf16x8 pa1, bf16x8 pa2, bf16x8 pa3) {
  const s16x4 l0 = tr_read<v_rd_off(D0, 0, 0)>(vb), h0 = tr_read<v_rd_off(D0, 0, 1)>(vb), l1 = tr_read<v_rd_off(D0, 1, 0)>(vb), h1 = tr_read<v_rd_off(D0, 1, 1)>(vb);
  const s16x4 l2 = tr_read<v_rd_off(D0, 2, 0)>(vb), h2 = tr_read<v_rd_off(D0, 2, 1)>(vb), l3 = tr_read<v_rd_off(D0, 3, 0)>(vb), h3 = tr_read<v_rd_off(D0, 3, 1)>(vb);
  asm volatile("s_waitcnt lgkmcnt(0)" ::: "memory"); ATT_SBAR();
#define ATT_PK(L, H) (bf16x8){L[0], L[1], L[2], L[3], H[0], H[1], H[2], H[3]}
  od = __builtin_amdgcn_mfma_f32_32x32x16_bf16(pa0, ATT_PK(l0, h0), od, 0, 0, 0);
  od = __builtin_amdgcn_mfma_f32_32x32x16_bf16(pa1, ATT_PK(l1, h1), od, 0, 0, 0);
  od = __builtin_amdgcn_mfma_f32_32x32x16_bf16(pa2, ATT_PK(l2, h2), od, 0, 0, 0);
  od = __builtin_amdgcn_mfma_f32_32x32x16_bf16(pa3, ATT_PK(l3, h3), od, 0, 0, 0);
#undef ATT_PK
}
__device__ __forceinline__ void pv_d0(f32x16* o, int vb, bf16x8 pa0, bf16x8 pa1, bf16x8 pa2, bf16x8 pa3) {
  pv_one<0>(o[0], vb, pa0, pa1, pa2, pa3); pv_one<1>(o[1], vb, pa0, pa1, pa2, pa3); pv_one<2>(o[2], vb, pa0, pa1, pa2, pa3); pv_one<3>(o[3], vb, pa0, pa1, pa2, pa3);
}
__device__ __forceinline__ void attn_unit(const bf16_t* __restrict__ Qb, const bf16_t* __restrict__ Kh, const bf16_t* __restrict__ Vh, bf16_t* __restrict__ Ob, int seq, char* lds) {
  int tid_o = threadIdx.x; asm volatile("" : "+v"(tid_o));
  const int tid = tid_o, wid = tid >> 6, lane = tid & 63, r32 = lane & 31, hi = lane >> 5;
  char* V_lds = lds; char* K_lds = lds + 2 * SHM_V;
  float* ws = (float*)(lds + SHM_WS) + wid * 64; char* qrl = lds + SHM_QR + wid * 4096 + lane * 16; float* li_l = ws; float* al_l = ws + 32;
  float m_reg = -1e30f, l_reg = 0; f32x16 o[4] = {}; bf16x8 qr[8];
  const bf16_t* Qw = Qb + (long)(wid * QBLK + r32) * LDQ + hi * 8;
#pragma unroll
  for (int d0 = 0; d0 < 8; ++d0) qr[d0] = *reinterpret_cast<const bf16x8*>(Qw + d0 * 16);
#pragma unroll
  for (int d0 = 8; d0 < ND0; ++d0) *reinterpret_cast<bf16x8*>(qrl + (d0 - 8) * 1024) = *reinterpret_cast<const bf16x8*>(Qw + d0 * 16);
  const int sr = tid >> 4, sc = (tid & 15) * 8, vst0 = v_st(sr, sc), vst1 = vst0 + 8192;
  const int kst0 = ATT_KSWZ(sr, sc * 2), kr2 = tid >> 3, kc2 = 128 + (tid & 7) * 8, kst2 = ATT_KSWZ(kr2, kc2 * 2);
  const int vb0 = (int)(uintptr_t)V_lds + v_rd_base(lane);
  bf16x8 vs0, vs1, ks0, ks1, ks2;
  const unsigned voff0 = (unsigned)(sr * LDV + sc) * 2u, koff0 = (unsigned)(sr * LDK + sc) * 2u, koff2 = (unsigned)(kr2 * LDK + kc2) * 2u;
#define ATT_SLOAD(k0) do { const char* vt_ = (const char*)Vh + (size_t)(k0) * (LDV * 2); const char* kt_ = (const char*)Kh + (size_t)(k0) * (LDK * 2); \
    vs0 = *reinterpret_cast<const bf16x8*>(vt_ + voff0); vs1 = *reinterpret_cast<const bf16x8*>(vt_ + 32 * LDV * 2 + voff0); \
    ks0 = *reinterpret_cast<const bf16x8*>(kt_ + koff0); ks1 = *reinterpret_cast<const bf16x8*>(kt_ + 32 * LDK * 2 + koff0); \
    ks2 = *reinterpret_cast<const bf16x8*>(kt_ + koff2); } while (0)
#define ATT_SWRITE(b) do { *(bf16x8*)(V_lds + (b) * SHM_V + vst0) = vs0; *(bf16x8*)(V_lds + (b) * SHM_V + vst1) = vs1; \
    *(bf16x8*)(K_lds + (b) * SHM_K + kst0) = ks0; *(bf16x8*)(K_lds + (b) * SHM_K + kst0 + 32 * 384) = ks1; *(bf16x8*)(K_lds + (b) * SHM_K + kst2) = ks2; } while (0)
#define ATT_SWAIT() asm volatile("s_waitcnt vmcnt(0)" ::: "memory")
#define ATT_RESC(a) do { if (__any((a) < 1.f)) { if (hi == 0) al_l[r32] = (a); asm volatile("s_waitcnt lgkmcnt(0)" ::: "memory"); \
    _Pragma("unroll") for (int d = 0; d < 4; ++d) _Pragma("unroll") for (int r = 0; r < 16; ++r) o[d][r] *= al_l[crow(r, hi)]; } } while (0)
  f32x16 pA0, pA1, pB0, pB1; float mnA, mnB, alA, alB; bf16x8 pa0, pa1, pa2, pa3; const int NT = seq / KVBLK;
  ATT_SLOAD(0); ATT_SWAIT(); ATT_SWRITE(0); __syncthreads();
  qkt(pA0, pA1, K_lds, qr, qrl, r32, hi); partialSM(pA0, pA1, m_reg, mnA, alA);
  ATT_SLOAD(KVBLK);
  ATT_SWAIT(); ATT_SWRITE(1); __syncthreads();
  for (int j = 1; j + 1 < NT; j += 2) {
    ATT_SBAR(); qkt(pB0, pB1, K_lds + SHM_K, qr, qrl, r32, hi);
    finishSM(pA0, pA1, alA, l_reg, pa0, pa1, pa2, pa3); ATT_SBAR();
    ATT_SLOAD((j + 1) * KVBLK); ATT_SBAR();
    pv_d0(o, vb0, pa0, pa1, pa2, pa3); partialSM(pB0, pB1, m_reg, mnB, alB);
    __syncthreads(); ATT_SWAIT(); ATT_SWRITE(0);
    ATT_RESC(alB); __syncthreads();
    ATT_SBAR(); qkt(pA0, pA1, K_lds, qr, qrl, r32, hi);
    finishSM(pB0, pB1, alB, l_reg, pa0, pa1, pa2, pa3); ATT_SBAR();
    ATT_SLOAD((j + 2) * KVBLK); ATT_SBAR();
    pv_d0(o, vb0 + SHM_V, pa0, pa1, pa2, pa3); partialSM(pA0, pA1, m_reg, mnA, alA);
    __syncthreads(); ATT_SWAIT(); ATT_SWRITE(1);
    ATT_RESC(alA); __syncthreads();
  }
  ATT_SBAR(); qkt(pB0, pB1, K_lds + SHM_K, qr, qrl, r32, hi);
  finishSM(pA0, pA1, alA, l_reg, pa0, pa1, pa2, pa3); ATT_SBAR();
  pv_d0(o, vb0, pa0, pa1, pa2, pa3); partialSM(pB0, pB1, m_reg, mnB, alB);
  __syncthreads(); ATT_RESC(alB);
  finishSM(pB0, pB1, alB, l_reg, pa0, pa1, pa2, pa3); ATT_SBAR();
  pv_d0(o, vb0 + SHM_V, pa0, pa1, pa2, pa3);
  if (hi == 0) li_l[r32] = l_reg; asm volatile("s_waitcnt lgkmcnt(0)" ::: "memory");
  float rli[16];
#pragma unroll
  for (int r = 0; r < 16; ++r) rli[r] = __builtin_amdgcn_rcpf(li_l[crow(r, hi)]);
  bf16_t* Ow = Ob + (long)(wid * QBLK) * LDO;
#pragma unroll
  for (int r = 0; r < 16; ++r) { const int orow = crow(r, hi);
#pragma unroll
    for (int d0 = 0; d0 < 4; ++d0) { const float a = o[d0][r] * rli[r]; const float bq = __shfl_xor(a, 1);
      if (!(lane & 1)) *(unsigned*)(Ow + (long)orow * LDO + d0 * 32 + r32) = cvtpk(a, bq); } }
  __syncthreads();
#undef ATT_SLOAD
#undef ATT_SWRITE
#undef ATT_SWAIT
#undef ATT_RESC
}
#undef ATT_SBAR
}
#define LAS __attribute__((address_space(3)))
#define XB_TMO      128
#define XB_XCNT(j)  (256  + 64 * (j))
#define XB_XSUB(j)  (1280 + 64 * (j))
#define XB_XGEN(j)  (2304 + 64 * (j))
#define XB_TOP      3328
#define XB_TOPGEN   3392
#define XCD_BAR_WORDS 3456
#define XB_SPIN_CAP (1u << 18)

__device__ __forceinline__ unsigned xb_ld(unsigned* p)              { return __hip_atomic_load(p, __ATOMIC_RELAXED, __HIP_MEMORY_SCOPE_AGENT); }
__device__ __forceinline__ unsigned xb_add(unsigned* p, unsigned v) { return __hip_atomic_fetch_add(p, v, __ATOMIC_RELAXED, __HIP_MEMORY_SCOPE_AGENT); }
__device__ __forceinline__ unsigned xb_xcc_id() { return (unsigned)__builtin_amdgcn_s_getreg((3 << 11) | 20) & 0xFu; }
#define XB_SPIN(cond, bar) do { unsigned _sp = 0; while (cond) { __builtin_amdgcn_s_sleep(1); \
    if ((++_sp & 255u) == 0u) { if (xb_ld(&(bar)[XB_TMO])) break; if (_sp > XB_SPIN_CAP) { atomicAdd(&(bar)[XB_TMO], 1u); break; } } } } while (0)

struct XcdBarrier {
    unsigned* bar; unsigned x;
    volatile LAS unsigned* st;
};

__device__ __forceinline__ XcdBarrier xcd_barrier_post(unsigned* bar, volatile LAS unsigned* st) {
    XcdBarrier b; b.bar = bar; b.x = xb_xcc_id(); b.st = st;
    if (threadIdx.x == 0) (void)xb_add(&bar[XB_XCNT(b.x)], 1u);
    return b;
}
__device__ __forceinline__ void xcd_barrier_complete(unsigned* bar, unsigned x, unsigned& nloc, unsigned& nx) {
    const unsigned G = gridDim.x * gridDim.y * gridDim.z;
    unsigned sum, cnt, mine, sp = 0u;
    for (;;) {
        sum = 0u; cnt = 0u; mine = 0u;
#pragma unroll
        for (unsigned j = 0; j < 16; ++j) { const unsigned c = xb_ld(&bar[XB_XCNT(j)]); sum += c; cnt += (c > 0u) ? 1u : 0u; mine = (j == x) ? c : mine; }
        if (sum == G) break;
        __builtin_amdgcn_s_sleep(1);
        if ((++sp & 255u) == 0u) { if (xb_ld(&bar[XB_TMO])) break; if (sp > XB_SPIN_CAP) { atomicAdd(&bar[XB_TMO], 1u); break; } }
    }
    nloc = mine > 0u ? mine : 1u; nx = cnt > 0u ? cnt : 1u;
}

__device__ __forceinline__ void xcd_barrier(const XcdBarrier& b) {
    asm volatile("s_waitcnt vmcnt(0)" ::: "memory");
    __syncthreads();
    if (threadIdx.x == 0) {
        unsigned* bar = b.bar;
        __builtin_amdgcn_s_waitcnt(0);
        unsigned nloc = b.st[0], nx = b.st[1];
        if (nloc == 0u) { xcd_barrier_complete(bar, b.x, nloc, nx); b.st[0] = nloc; b.st[1] = nx; }
        const unsigned old = xb_add(&bar[XB_XSUB(b.x)], 1u);
        const unsigned gen = old / nloc;
        if (old + 1u == (gen + 1u) * nloc) {
            __builtin_amdgcn_fence(__ATOMIC_RELEASE, "agent");
            asm volatile("s_waitcnt vmcnt(0)" ::: "memory");
            const unsigned og = xb_add(&bar[XB_TOP], 1u);
            const unsigned tg = og / nx;
            if (og + 1u == (tg + 1u) * nx) xb_add(&bar[XB_TOPGEN], 1u);
            else XB_SPIN(xb_ld(&bar[XB_TOPGEN]) == tg, bar);
            __builtin_amdgcn_fence(__ATOMIC_ACQUIRE, "agent");
            xb_add(&bar[XB_XGEN(b.x)], 1u);
            asm volatile("s_waitcnt vmcnt(0)" ::: "memory");
        } else {
            XB_SPIN(xb_ld(&bar[XB_XGEN(b.x)]) == gen, bar);
            __builtin_amdgcn_fence(__ATOMIC_ACQUIRE, "agent");
            asm volatile("s_waitcnt vmcnt(0)" ::: "memory");
        }
    }
    __syncthreads();
}

constexpr int NWAVES = 8;
constexpr int DM = 2048, NB = 4, SEQ = 4096, CTXL = 256, NLAYER = 2;
constexpr int TL = NB * SEQ, TC = NB * CTXL, TT = TL + TC;
constexpr int KEYS = SEQ + CTXL;
constexpr int NIN = 11072, NINP = 11264;
constexpr int PC_KR = 256, PC_Q = 512, PC_CB = 1024, PC_CC = 3072, PC_CU = 5120, PC_GA = 7168, PC_GB = 9216;
constexpr int NEXP = 16384, PEER_H = 8, TOPK = 16;

constexpr size_t MiB = 1u << 20;
constexpr size_t WS_CTL = 0, CTL_ZERO_BYTES = 2 * MiB;
constexpr size_t WS_ADA = 2 * MiB;
constexpr size_t WS_ROPE = 3 * MiB;
constexpr size_t WS_CTXB = 4 * MiB;
constexpr size_t WS_IDX = 12 * MiB, WS_GW = 21 * MiB;
constexpr size_t WS_W = 30 * MiB, W_LAYER = 81 * MiB;
constexpr size_t WO_IN = 0, WO_Q = 44 * MiB, WO_KV = 47 * MiB, WO_A = 49 * MiB, WO_C = 57 * MiB, WO_O = 65 * MiB, WO_EFF = 73 * MiB;
constexpr size_t WS_UB = 192 * MiB, WS_VB = 256 * MiB;
constexpr size_t WS_USC = WS_UB + 40 * MiB, WS_VSC = WS_VB + 40 * MiB;
constexpr size_t WS_P = 320 * MiB;
constexpr size_t WS_KA = 694 * MiB, WS_VA = 796 * MiB;
constexpr size_t WS_KN = 864 * MiB, WS_QR = 932 * MiB;
constexpr size_t WS_HB = 1034 * MiB;
constexpr size_t WS_END = 1102 * MiB;
static_assert(WS_P + (size_t)TT * NINP * 2 <= WS_KA && WS_KA + (size_t)NB * KEYS * 3072 * 2 <= WS_VA && WS_VA + (size_t)NB * KEYS * 2048 * 2 <= WS_KN && WS_KN + (size_t)TT * 2048 * 2 <= WS_QR && WS_QR + (size_t)TT * 3072 * 2 <= WS_HB && WS_HB + (size_t)TT * 2048 * 2 <= WS_END, "d_ws map");
static_assert(WS_W + 2 * W_LAYER <= WS_UB && WS_IDX + (size_t)TT * 128 * 4 <= WS_GW && WS_GW + (size_t)TT * 128 * 4 <= WS_W, "d_ws map 2");
constexpr int CW_BAR = 4096;
constexpr int CW_SSQ = 16384;
static_assert((CW_SSQ + 8 * TT) * 4 <= (int)CTL_ZERO_BYTES, "CTL words inside the memset region");

constexpr int RING_OFF = 0, RING_BYTES = 131072;
constexpr int LDSCTL_OFF = RING_BYTES, MISC_OFF = LDSCTL_OFF + 320;
constexpr int LDS_BYTES = 147456;
typedef unsigned short bf16;
typedef unsigned v4u __attribute__((ext_vector_type(4)));
typedef float f32x4 __attribute__((ext_vector_type(4)));
typedef __bf16 bf16x2_t __attribute__((ext_vector_type(2)));
#define LDS_WAIT() asm volatile("s_waitcnt lgkmcnt(0)" ::: "memory")
__device__ __forceinline__ unsigned f2bf(float f) { unsigned u = __builtin_bit_cast(unsigned, f); return (u + 0x7fffu + ((u >> 16) & 1u)) >> 16; }
__device__ __forceinline__ unsigned pk2(float lo, float hi) { return pg8::cvt_pk_bf16(lo, hi); }
__device__ __forceinline__ float blo(unsigned w) { return __uint_as_float(w << 16); }
__device__ __forceinline__ float bhi(unsigned w) { return __uint_as_float(w & 0xffff0000u); }
__device__ __forceinline__ float dot2bf(unsigned a, unsigned b, float c) { return __builtin_amdgcn_fdot2_f32_bf16(__builtin_bit_cast(bf16x2_t, a), __builtin_bit_cast(bf16x2_t, b), c, false); }
__device__ __forceinline__ float wave_sum(float v) {
#pragma unroll
    for (int o = 1; o < 64; o <<= 1) v += __shfl_xor(v, o);
    return v;
}

struct Frame {
    LAS unsigned char* lds;
    volatile LAS unsigned* MISC;
    unsigned* ctl;
    int tid, lane, wave;
    int vcu, G;
};
struct Args { const float* in[23]; float* out; unsigned char* ws; int ph_lo, ph_hi, li, pad; };

__device__ __forceinline__ void ada_item(Frame& F, const float* c, const float* cctx, const float* wmod, const float* bmod, float* ADA, int item) {
    const int l = item / 96, n0 = (item % 96) * 128;
    LAS float* sc = (LAS float*)(F.lds);
    LAS float* red = (LAS float*)(F.lds + 40960);
    for (int i = F.tid; i < 5 * 2048; i += 512) { const float v = (i < 4 * 2048) ? c[i] : cctx[i - 4 * 2048]; sc[i] = v / (1.0f + __expf(-v)); }
    __syncthreads();
    const float* wp = wmod + (size_t)l * 2048 * 12288 + n0 + 2 * F.lane;
    float a[5][2];
#pragma unroll
    for (int r = 0; r < 5; ++r) { a[r][0] = 0.f; a[r][1] = 0.f; }
    const int kb = F.wave * 256;
#pragma unroll 4
    for (int k = 0; k < 256; ++k) { const float2 w = *(const float2*)(wp + (size_t)(kb + k) * 12288);
#pragma unroll
        for (int r = 0; r < 5; ++r) { const float s = sc[r * 2048 + kb + k]; a[r][0] += s * w.x; a[r][1] += s * w.y; } }
#pragma unroll
    for (int r = 0; r < 5; ++r) { red[(F.wave * 5 + r) * 128 + 2 * F.lane] = a[r][0]; red[(F.wave * 5 + r) * 128 + 2 * F.lane + 1] = a[r][1]; }
    __syncthreads();
    for (int i = F.tid; i < 5 * 128; i += 512) { const int r = i >> 7, n = i & 127; float s = bmod[l * 12288 + n0 + n];
#pragma unroll
        for (int w = 0; w < 8; ++w) s += red[(w * 5 + r) * 128 + n];
        ADA[((size_t)l * 5 + r) * 12288 + n0 + n] = s; }
    __syncthreads();
}
__device__ __forceinline__ void transpose_item(const float* W, int ldw, int K, bf16* WT, int ndst, int nsrc, int k0, const float* gain, LAS float* scr, int lane) {
#pragma unroll 8
    for (int i = 0; i < 32; ++i) { const int kk = 2 * i + (lane >> 5); float v = 0.f; if (nsrc >= 0) { v = W[(size_t)(k0 + kk) * ldw + nsrc + (lane & 31)]; if (gain) v *= gain[k0 + kk]; } scr[kk * 33 + (lane & 31)] = v; }
    LDS_WAIT(); asm volatile("" ::: "memory");
    const int c = lane & 7;
#pragma unroll
    for (int j = 0; j < 4; ++j) { const int n = (lane >> 3) + 8 * j; const LAS float* s = scr + (8 * c) * 33 + n;
        v4u o; o.x = pk2(s[0 * 33], s[1 * 33]); o.y = pk2(s[2 * 33], s[3 * 33]); o.z = pk2(s[4 * 33], s[5 * 33]); o.w = pk2(s[6 * 33], s[7 * 33]);
        *(v4u*)(WT + (size_t)(ndst + n) * K + k0 + 8 * c) = o; }
    LDS_WAIT(); asm volatile("" ::: "memory");
}
__device__ __forceinline__ void weff_item(Frame& F, const float* wq, const float* sk, bf16* WeffT, int item) {
    const int hp = item >> 5, k0 = (item & 31) * 64;
    LAS float* s_sk = (LAS float*)(F.lds);
    LAS float* s_wq = (LAS float*)(F.lds + 128 * 132 * 4);
    for (int i = F.tid; i < 128 * 32; i += 512) { const int n = i >> 5, d4 = (i & 31) * 4; *(LAS f32x4*)(s_sk + n * 132 + d4) = *(const f32x4*)(sk + ((size_t)hp * 128 + n) * 128 + d4); }
    for (int i = F.tid; i < 64 * 32; i += 512) { const int k = i >> 5, d4 = (i & 31) * 4; *(LAS f32x4*)(s_wq + k * 132 + d4) = *(const f32x4*)(wq + (size_t)(k0 + k) * 2048 + hp * 128 + d4); }
    __syncthreads();
    const int n = F.tid & 127, kg = F.tid >> 7;
    float acc[16];
#pragma unroll
    for (int i = 0; i < 16; ++i) acc[i] = 0.f;
    for (int d4 = 0; d4 < 128; d4 += 4) { const f32x4 a = *(const LAS f32x4*)(s_sk + n * 132 + d4);
#pragma unroll
        for (int i = 0; i < 16; ++i) { const f32x4 b = *(const LAS f32x4*)(s_wq + (kg * 16 + i) * 132 + d4); acc[i] += (a[0] * b[0] + a[1] * b[1]) + (a[2] * b[2] + a[3] * b[3]); } }
    v4u o0, o1; o0.x = pk2(acc[0], acc[1]); o0.y = pk2(acc[2], acc[3]); o0.z = pk2(acc[4], acc[5]); o0.w = pk2(acc[6], acc[7]);
    o1.x = pk2(acc[8], acc[9]); o1.y = pk2(acc[10], acc[11]); o1.z = pk2(acc[12], acc[13]); o1.w = pk2(acc[14], acc[15]);
    bf16* dst = WeffT + (size_t)(hp * 128 + n) * 2048 + k0 + kg * 16; *(v4u*)dst = o0; *(v4u*)(dst + 8) = o1;
    __syncthreads();
}
template <class T> __device__ __forceinline__ T ldu6(const void* base, unsigned off) { return *(const T*)((const char*)base + off); }
__device__ __forceinline__ void norm_mod_row(const float* xrow, const float* gain, const float* shift, const float* scale, bf16* orow, int lane) {
    const unsigned l16 = (unsigned)lane * 16u; f32x4 v[8]; float s = 0.f;
#pragma unroll
    for (int j = 0; j < 8; ++j) { v[j] = ldu6<f32x4>(xrow, l16 + j * 1024); s += (v[j][0] * v[j][0] + v[j][1] * v[j][1]) + (v[j][2] * v[j][2] + v[j][3] * v[j][3]); }
    const float r = __builtin_amdgcn_rsqf(wave_sum(s) * (1.0f / 2048.0f) + pg8::RMS_EPS);
#pragma unroll
    for (int j = 0; j < 8; ++j) { const f32x4 g = ldu6<f32x4>(gain, l16 + j * 1024), sh = ldu6<f32x4>(shift, l16 + j * 1024), sc = ldu6<f32x4>(scale, l16 + j * 1024);
        const f32x4 y = (v[j] * r * g) * (sc + 1.0f) + sh;
        *(unsigned long long*)((char*)orow + (unsigned)lane * 8u + j * 512) = (unsigned long long)pk2(y[0], y[1]) | ((unsigned long long)pk2(y[2], y[3]) << 32); }
}
__device__ __forceinline__ int row_bi(int row) { return row < TL ? (row >> 12) : 4; }

template <int MODE> __device__ __forceinline__ void qk_norm_row(int row, const bf16* KN, const bf16* P, bf16* KA, bf16* QR, const float* gain, const float2* rope, int lane) {
    const int h = lane >> 2, j = lane & 3, e0 = 48 * j;
    v4u w[6];
#pragma unroll
    for (int c = 0; c < 6; ++c) { const int e = e0 + 8 * c;
        if (MODE == 1) w[c] = *(const v4u*)(QR + (size_t)row * 3072 + h * 192 + e);
        else w[c] = (e < 128) ? *(const v4u*)(KN + (size_t)row * 2048 + h * 128 + e) : *(const v4u*)(P + (size_t)row * NINP + PC_KR + (e - 128)); }
    float x[48]; float s = 0.f;
#pragma unroll
    for (int c = 0; c < 6; ++c) { x[8 * c + 0] = blo(w[c].x); x[8 * c + 1] = bhi(w[c].x); x[8 * c + 2] = blo(w[c].y); x[8 * c + 3] = bhi(w[c].y); x[8 * c + 4] = blo(w[c].z); x[8 * c + 5] = bhi(w[c].z); x[8 * c + 6] = blo(w[c].w); x[8 * c + 7] = bhi(w[c].w); }
#pragma unroll
    for (int i = 0; i < 48; ++i) s += x[i] * x[i];
    s += __shfl_xor(s, 1); s += __shfl_xor(s, 2);
    const float r = __builtin_amdgcn_rsqf(s * (1.0f / 192.0f) + pg8::RMS_EPS);
#pragma unroll
    for (int i = 0; i < 48; i += 4) { const f32x4 g = *(const f32x4*)(gain + e0 + i); x[i] *= r * g[0]; x[i + 1] *= r * g[1]; x[i + 2] *= r * g[2]; x[i + 3] *= r * g[3]; }
    if (row < TL) { const int pos = row & 4095;
#pragma unroll
        for (int i = 0; i < 48; i += 2) { const int e = e0 + i; if (e >= 128) { const float2 cs = rope[pos * 32 + ((e - 128) >> 1)]; const float a = x[i], b = x[i + 1]; x[i] = a * cs.x - b * cs.y; x[i + 1] = a * cs.y + b * cs.x; } } }
    bf16* dst = (MODE == 1) ? QR + (size_t)row * 3072 + h * 192 + e0 : KA + (size_t)pg8::key_row(row) * 3072 + h * 192 + e0;
#pragma unroll
    for (int c = 0; c < 6; ++c) { v4u o; o.x = pk2(x[8 * c], x[8 * c + 1]); o.y = pk2(x[8 * c + 2], x[8 * c + 3]); o.z = pk2(x[8 * c + 4], x[8 * c + 5]); o.w = pk2(x[8 * c + 6], x[8 * c + 7]); *(v4u*)(dst + 8 * c) = o; }
}
__device__ __forceinline__ void conv_item(const bf16* P, const float* cw, bf16* CV, int row, int ch) {
    const int pos = row < TL ? (row & 4095) : ((row - TL) & 255), len = row < TL ? SEQ : CTXL;
    const bf16* pr = P + (size_t)row * NINP + ch;
    float z[3][8];
#pragma unroll
    for (int j = 0; j < 3; ++j) { const int p = pos + j - 1; const bool ok = (p >= 0) && (p < len);
        if (ok) { const v4u c = *(const v4u*)(pr + (long)(j - 1) * NINP + PC_CC), u = *(const v4u*)(pr + (long)(j - 1) * NINP + PC_CU);
            z[j][0] = blo(c.x) * blo(u.x); z[j][1] = bhi(c.x) * bhi(u.x); z[j][2] = blo(c.y) * blo(u.y); z[j][3] = bhi(c.y) * bhi(u.y);
            z[j][4] = blo(c.z) * blo(u.z); z[j][5] = bhi(c.z) * bhi(u.z); z[j][6] = blo(c.w) * blo(u.w); z[j][7] = bhi(c.w) * bhi(u.w); }
        else {
#pragma unroll
            for (int i = 0; i < 8; ++i) z[j][i] = 0.f; } }
    const v4u b = *(const v4u*)(pr + PC_CB); const float bg[8] = {blo(b.x), bhi(b.x), blo(b.y), bhi(b.y), blo(b.z), bhi(b.z), blo(b.w), bhi(b.w)};
    float y[8];
#pragma unroll
    for (int i = 0; i < 8; ++i) y[i] = bg[i] * (cw[ch + i] * z[0][i] + cw[2048 + ch + i] * z[1][i] + cw[4096 + ch + i] * z[2][i]);
    v4u o; o.x = pk2(y[0], y[1]); o.y = pk2(y[2], y[3]); o.z = pk2(y[4], y[5]); o.w = pk2(y[6], y[7]);
    *(v4u*)(CV + (size_t)row * 2048 + ch) = o;
}

__device__ __forceinline__ int ord_key(float f) { int k = __float_as_int(f); return k ^ ((k >> 31) & 0x7fffffff); }
__device__ __forceinline__ float ord_val(int k) { return __int_as_float(k ^ ((k >> 31) & 0x7fffffff)); }
#define TOPK_INSERT(T, X) do { int x_ = (X); _Pragma("unroll") for (int i_ = 0; i_ < 16; ++i_) { const int hi_ = max(T[i_], x_); x_ = min(T[i_], x_); T[i_] = hi_; } } while (0)
__device__ __forceinline__ void topk_item(const float* SC, int* IDX, float* GW, int row0, LAS int* lists, int lane) {
#pragma unroll 1
    for (int pp = 0; pp < 2; ++pp) {
        const int L = pp * 64 + lane, tl = L >> 4, hp = L & 15;
        const f32x4* src = (const f32x4*)(SC + (size_t)(row0 + tl) * 2048 + hp * 128);
        int top[16];
#pragma unroll
        for (int i = 0; i < 16; ++i) top[i] = (int)0x80000000;
#pragma unroll 2
        for (int e4 = 0; e4 < 32; ++e4) { const f32x4 v = src[e4];
#pragma unroll
            for (int c = 0; c < 4; ++c) TOPK_INSERT(top, (ord_key(v[c]) & ~0x7F) | (e4 * 4 + c)); }
#pragma unroll
        for (int i = 0; i < 16; ++i) lists[i * 128 + L] = top[i];
    }
    LDS_WAIT(); asm volatile("" ::: "memory");
    const int tl = lane >> 3, h = lane & 7, LA = tl * 16 + 2 * h, LB = LA + 1;
    float va[16], vb[16];
#pragma unroll
    for (int i = 0; i < 16; ++i) { va[i] = ord_val(lists[i * 128 + LA] & ~0x7F); vb[i] = ord_val(lists[i * 128 + LB] & ~0x7F); }
    int best[16];
#pragma unroll
    for (int i = 0; i < 16; ++i) best[i] = (int)0x80000000;
#pragma unroll
    for (int i = 0; i < 16; ++i)
#pragma unroll
        for (int j = 0; j < 16; ++j) if ((i + 1) * (j + 1) <= 16) TOPK_INSERT(best, (ord_key(va[i] + vb[j]) & ~0xFF) | (i << 4) | j);
    float sc[16]; float ssum = 0.f; const float smax = ord_val(best[0] & ~0xFF);
    int ex[16];
#pragma unroll
    for (int k = 0; k < 16; ++k) { const int code = best[k] & 0xFF, i = code >> 4, j = code & 15;
        ex[k] = (lists[i * 128 + LA] & 0x7F) * 128 + (lists[j * 128 + LB] & 0x7F);
        sc[k] = __expf(ord_val(best[k] & ~0xFF) - smax); ssum += sc[k]; }
    const float inv = 1.0f / ssum;
    int* ip = IDX + (size_t)(row0 + tl) * 128 + h * 16; float* gp = GW + (size_t)(row0 + tl) * 128 + h * 16;
#pragma unroll
    for (int k = 0; k < 16; k += 4) { *(int4*)(ip + k) = make_int4(ex[k], ex[k + 1], ex[k + 2], ex[k + 3]); *(f32x4*)(gp + k) = (f32x4){sc[k] * inv, sc[k + 1] * inv, sc[k + 2] * inv, sc[k + 3] * inv}; }
    LDS_WAIT(); asm volatile("" ::: "memory");
}

template <class T> __device__ __forceinline__ T ldu(const void* base, unsigned off) { return *(const T*)((const char*)base + off); }
template <class T> __device__ __forceinline__ void stu(void* base, unsigned off, T v) { *(T*)((char*)base + off) = v; }
typedef float f32x2_t __attribute__((ext_vector_type(2)));
#define PEER_NB 4
__device__ __forceinline__ void peer_row(const bf16* hrow, const int* idx, const float* gw, const unsigned char* UB, const unsigned char* VB, const float* USC, const float* VSC, float (&out)[32], int lane) {
    const unsigned l16 = (unsigned)lane * 16u, l32 = (unsigned)lane * 32u;
    float hf[32];
#pragma unroll
    for (int j = 0; j < 2; ++j)
#pragma unroll
        for (int q = 0; q < 2; ++q) { const v4u w = ldu<v4u>(hrow, l32 + j * 2048 + q * 16);
            hf[16 * j + 8 * q + 0] = blo(w.x); hf[16 * j + 8 * q + 1] = bhi(w.x); hf[16 * j + 8 * q + 2] = blo(w.y); hf[16 * j + 8 * q + 3] = bhi(w.y);
            hf[16 * j + 8 * q + 4] = blo(w.z); hf[16 * j + 8 * q + 5] = bhi(w.z); hf[16 * j + 8 * q + 6] = blo(w.w); hf[16 * j + 8 * q + 7] = bhi(w.w); }
#pragma unroll
    for (int i = 0; i < 32; ++i) out[i] = 0.f;
    const int mybt = (lane >> 2) & 3; const bool b5 = lane & 32, b4 = lane & 16;
    const unsigned myk4 = (unsigned)(mybt * 4 + ((lane >> 5) & 1) * 2 + ((lane >> 4) & 1)) * 4u;
#pragma unroll 1
    for (int hd = 0; hd < 8; ++hd) {
        const int my_e = ldu<int>(idx + hd * 16, myk4); const float my_g = ldu<float>(gw + hd * 16, myk4);
        const float my_su = USC[my_e], my_sv = VSC[my_e];
        float tot = 0.f;
#pragma unroll 1
        for (int bt = 0; bt < 4; bt += PEER_NB / 4) {
            v4u w[PEER_NB][2];
#pragma unroll
            for (int e = 0; e < PEER_NB; ++e) { const int ei = __builtin_amdgcn_readlane(my_e, (bt + (e >> 2)) * 4 + ((e >> 1) & 1) * 32 + (e & 1) * 16); const unsigned char* up = UB + (size_t)ei * 2048;
#pragma unroll
                for (int j = 0; j < 2; ++j) w[e][j] = ldu<v4u>(up, l16 + j * 1024); }
            float d[PEER_NB];
#pragma unroll
            for (int e = 0; e < PEER_NB; ++e) { float a0 = 0.f, a1 = 0.f;
#pragma unroll
                for (int j = 0; j < 2; ++j)
#pragma unroll
                    for (int q = 0; q < 4; ++q) { const int wd = (int)w[e][j][q]; const f32x2_t lo = __builtin_amdgcn_cvt_pk_f32_fp8(wd, false), hi = __builtin_amdgcn_cvt_pk_f32_fp8(wd, true);
                        a0 += lo[0] * hf[16 * j + 4 * q + 0]; a1 += lo[1] * hf[16 * j + 4 * q + 1]; a0 += hi[0] * hf[16 * j + 4 * q + 2]; a1 += hi[1] * hf[16 * j + 4 * q + 3]; }
                d[e] = a0 + a1; __builtin_amdgcn_sched_barrier(0); }
#pragma unroll
            for (int g = 0; g < PEER_NB / 4; ++g) {
                float t2[2], t1;
#pragma unroll
                for (int i = 0; i < 2; ++i) { const float mine = b5 ? d[4 * g + 2 + i] : d[4 * g + i], send = b5 ? d[4 * g + i] : d[4 * g + 2 + i]; t2[i] = mine + __shfl_xor(send, 32); }
                { const float mine = b4 ? t2[1] : t2[0], send = b4 ? t2[0] : t2[1]; t1 = mine + __shfl_xor(send, 16); }
                t1 += __shfl_xor(t1, 8); t1 += __shfl_xor(t1, 4); t1 += __shfl_xor(t1, 2); t1 += __shfl_xor(t1, 1);
                tot = (bt + g == mybt) ? t1 : tot; }
        }
        tot *= my_su;
        const float wgt = my_g * my_sv * 0.5f * tot * (1.0f + erff(tot * 0.70710678118654752f));
#pragma unroll 1
        for (int bt = 0; bt < 4; bt += PEER_NB / 4) {
            v4u w[PEER_NB][2];
#pragma unroll
            for (int e = 0; e < PEER_NB; ++e) { const int ei = __builtin_amdgcn_readlane(my_e, (bt + (e >> 2)) * 4 + ((e >> 1) & 1) * 32 + (e & 1) * 16); const unsigned char* vp = VB + (size_t)ei * 2048;
#pragma unroll
                for (int j = 0; j < 2; ++j) w[e][j] = ldu<v4u>(vp, l16 + j * 1024); }
#pragma unroll
            for (int e = 0; e < PEER_NB; ++e) { const float we = __int_as_float(__builtin_amdgcn_readlane(__float_as_int(wgt), (bt + (e >> 2)) * 4 + ((e >> 1) & 1) * 32 + (e & 1) * 16));
#pragma unroll
                for (int j = 0; j < 2; ++j)
#pragma unroll
                    for (int q = 0; q < 4; ++q) { const int wd = (int)w[e][j][q]; const f32x2_t lo = __builtin_amdgcn_cvt_pk_f32_fp8(wd, false), hi = __builtin_amdgcn_cvt_pk_f32_fp8(wd, true);
                        out[16 * j + 4 * q + 0] += we * lo[0]; out[16 * j + 4 * q + 1] += we * lo[1]; out[16 * j + 4 * q + 2] += we * hi[0]; out[16 * j + 4 * q + 3] += we * hi[1]; }
                __builtin_amdgcn_sched_barrier(0); }
        }
    }
}
__device__ __forceinline__ void fp8_row(const float* src, unsigned char* dst, float* scale_out, int lane) {
    const unsigned l64 = (unsigned)lane * 64u, l16 = (unsigned)lane * 16u;
    f32x4 v[2][4]; float m = 0.f;
#pragma unroll
    for (int j = 0; j < 2; ++j)
#pragma unroll
        for (int q = 0; q < 4; ++q) { v[j][q] = ldu<f32x4>(src, l64 + j * 4096 + q * 16); m = fmaxf(m, fmaxf(fmaxf(fabsf(v[j][q][0]), fabsf(v[j][q][1])), fmaxf(fabsf(v[j][q][2]), fabsf(v[j][q][3])))); }
#pragma unroll
    for (int o = 1; o < 64; o <<= 1) m = fmaxf(m, __shfl_xor(m, o));
    const float inv = m > 0.f ? 448.0f / m : 0.f;
    if (lane == 0) *scale_out = m * (1.0f / 448.0f);
#pragma unroll
    for (int j = 0; j < 2; ++j) { v4u o;
#pragma unroll
        for (int q = 0; q < 4; ++q) { int wd = __builtin_amdgcn_cvt_pk_fp8_f32(v[j][q][0] * inv, v[j][q][1] * inv, 0, false); wd = __builtin_amdgcn_cvt_pk_fp8_f32(v[j][q][2] * inv, v[j][q][3] * inv, wd, true); o[q] = (unsigned)wd; }
        stu<v4u>(dst, l16 + j * 1024, o); }
}

#if defined(__HIP_DEVICE_COMPILE__)
#define ASSUME_GLOBAL(p) do { __builtin_assume(!__builtin_amdgcn_is_shared((const __attribute__((address_space(0))) void*)(p))); __builtin_assume(!__builtin_amdgcn_is_private((const __attribute__((address_space(0))) void*)(p))); } while (0)
#else
#define ASSUME_GLOBAL(p) do { } while (0)
#endif
__device__ __forceinline__ const float* inp_ptr(const Args& a, int k) { asm volatile("" : "+s"(k)); const float* p = a.in[k]; ASSUME_GLOBAL(p); return p; }
constexpr int NPHASE = 22;
__global__ void __launch_bounds__(NWAVES * 64, 2) fwd_kernel(Args args) {
    extern __shared__ __attribute__((aligned(16))) unsigned char lds[];
    Frame F;
    F.lds = (LAS unsigned char*)lds;
    F.MISC = (volatile LAS unsigned*)(F.lds + MISC_OFF);
    F.tid = threadIdx.x; F.lane = F.tid & 63; F.wave = __builtin_amdgcn_readfirstlane(F.tid >> 6);
    F.G = gridDim.x; { const int bx = blockIdx.x; F.vcu = (F.G % 8 == 0) ? (bx % 8) * (F.G / 8) + bx / 8 : bx; }
    F.ctl = (unsigned*)(args.ws + WS_CTL);
    for (int u = F.tid; u < (LDS_BYTES - LDSCTL_OFF) / 4; u += NWAVES * 64) ((LAS unsigned*)(F.lds + LDSCTL_OFF))[u] = 0u;
    __syncthreads();
    XcdBarrier bar = xcd_barrier_post((unsigned*)(F.ctl + CW_BAR), F.MISC + 8);
    const int lo = args.ph_lo, hi = args.ph_hi;
#define IN(k) (lo <= (k) && (k) < hi)
#ifndef PHMASK
#define PHMASK 0xFFF
#endif
#define EN(b) ((PHMASK >> (b)) & 1)
#define PHASE_BEGIN() int ptid_ = threadIdx.x; asm volatile("" : "+v"(ptid_)); Frame Fp = F; Fp.tid = ptid_; Fp.lane = ptid_ & 63; const int gt = bid * 512 + Fp.tid; (void)gt; \
    size_t oz_ = 0; asm volatile("" : "+s"(oz_)); unsigned char* ws = args.ws + oz_; float* xout = args.out + oz_; (void)xout
#define INP(k_) (args.in[k_] + oz_)
#define WSP(T_, off_) ((T_*)(ws + (off_)))
#define SEAM(k) do { if (IN(k) && IN((k) + 1)) xcd_barrier(bar); } while (0)
    const int gw = F.vcu * NWAVES + F.wave, NGW = F.G * NWAVES, bid = F.vcu;
    const int NGT = F.G * 512;

    if (EN(0) && IN(0)) { PHASE_BEGIN();
        const float* c_in = INP(1); const float* cctx_in = INP(3); const float* w_mod = INP(4); const float* b_mod = INP(5); const float* w_in = INP(7);
        const float* q_a_norm = INP(8); const float* kv_a_norm = INP(9); const float* w_q_up = INP(10); const float* w_kv_up = INP(11);
        const float* w_attn_out = INP(15); const float* w_conv_out = INP(16); const float* w_o = INP(17); const float* w_query = INP(19); const float* sub_keys = INP(20);
        float* ADA = WSP(float, WS_ADA); float2* ROPE = WSP(float2, WS_ROPE);
        for (int it = bid; it < 192; it += F.G) ada_item(Fp, c_in, cctx_in, w_mod, b_mod, ADA, it);
        {   LAS float* scr = (LAS float*)(F.lds + RING_OFF + F.wave * 16384);
            constexpr int I_IN = 32 * 352, I_Q = 8 * 96, I_KV = 4 * 128, I_SQ = 32 * 64, I_L = I_IN + I_Q + I_KV + 3 * I_SQ;
            for (int it = gw; it < 2 * I_L; it += NGW) {
                const int l = it / I_L; int r = it % I_L; bf16* wl = (bf16*)(ws + WS_W + (size_t)l * W_LAYER);
                if (r < I_IN) { const int kb = r / 352, n0 = (r % 352) * 32; const int ns = n0 < 320 ? n0 : (n0 < 512 ? -1 : n0 - 192);
                    transpose_item(w_in + (size_t)l * 2048 * NIN, NIN, 2048, (bf16*)((char*)wl + WO_IN), n0, ns, kb * 64, nullptr, scr, Fp.lane); continue; } r -= I_IN;
                if (r < I_Q) { const int kb = r / 96, n0 = (r % 96) * 32;
                    transpose_item(w_q_up + (size_t)l * 512 * 3072, 3072, 512, (bf16*)((char*)wl + WO_Q), n0, n0, kb * 64, q_a_norm + l * 512, scr, Fp.lane); continue; } r -= I_Q;
                if (r < I_KV) { const int kb = r / 128, n0 = (r % 128) * 32; const int ns = n0 < 2048 ? (n0 >> 7) * 256 + (n0 & 127) : ((n0 - 2048) >> 7) * 256 + 128 + ((n0 - 2048) & 127);
                    transpose_item(w_kv_up + (size_t)l * 256 * 4096, 4096, 256, (bf16*)((char*)wl + WO_KV), n0, ns, kb * 64, kv_a_norm + l * 256, scr, Fp.lane); continue; } r -= I_KV;
                const int m = r / I_SQ; r %= I_SQ; const int kb = r / 64, n0 = (r % 64) * 32;
                const float* src = (m == 0 ? w_attn_out : (m == 1 ? w_conv_out : w_o)) + (size_t)l * 2048 * 2048;
                transpose_item(src, 2048, 2048, (bf16*)((char*)wl + (m == 0 ? WO_A : (m == 1 ? WO_C : WO_O))), n0, n0, kb * 64, nullptr, scr, Fp.lane);
            }
        }
        __syncthreads();
        for (int it = bid; it < 2 * 512; it += F.G) { const int l = it >> 9;
            weff_item(Fp, w_query + (size_t)l * 2048 * 2048, sub_keys + (size_t)l * 16 * 128 * 128, (bf16*)(ws + WS_W + (size_t)l * W_LAYER + WO_EFF), it & 511); }
        for (int i = gt; i < 4096 * 32; i += NGT) { const int pos = i >> 5, p = i & 31; const float fpos = (float)(p < 16 ? (pos >> 6) : (pos & 63));
            const float invf = exp2f(-(float)(p & 15) * (13.287712379549449f / 16.0f)); const float ang = fpos * invf;
            float rev = ang * 0.15915494309189535f; rev -= rintf(rev); ROPE[i] = make_float2(__builtin_amdgcn_cosf(rev), __builtin_amdgcn_sinf(rev)); }
    }
    SEAM(0);
    if (EN(1) && IN(1)) { PHASE_BEGIN();
        const float* x_in = INP(0); const float* ctx_in = INP(2); const float* ln_mix = INP(6); const float* ADA = WSP(float, WS_ADA); bf16* HB = WSP(bf16, WS_HB);
        for (int row_ = gw; row_ < TT; row_ += NGW) { int row = row_; asm volatile("" : "+s"(row)); const int bi = row_bi(row); const float* ap = ADA + (size_t)bi * 12288;
            norm_mod_row(row < TL ? x_in + (size_t)row * DM : ctx_in + (size_t)(row - TL) * DM, ln_mix, ap, ap + 2048, HB + (size_t)row * DM, Fp.lane); }
    }
    SEAM(1);
#pragma unroll 1
    for (int l = 0; l < NLAYER; ++l) {
        const int pb = 2 + 10 * l;
        const int MR = (l == 0) ? TT : TL;
#define LAYER_W() bf16* wl = WSP(bf16, WS_W + (size_t)l * W_LAYER); (void)wl
#define LAYER_SSQ() unsigned long long* ssq_kv = (unsigned long long*)((unsigned*)(ws + WS_CTL) + CW_SSQ) + (size_t)(2 * l) * TT; unsigned long long* ssq_q = ssq_kv + TT; (void)ssq_q
#define LAYER_ADA() const float* ada_l = WSP(float, WS_ADA) + (size_t)l * 5 * 12288
        if (EN(2) && IN(pb + 0)) { PHASE_BEGIN();
            LAYER_W(); LAYER_SSQ(); const bf16* Win_t = (const bf16*)((char*)wl + WO_IN); bf16* HB = WSP(bf16, WS_HB); bf16* P = WSP(bf16, WS_P);
            { pg8::Gemm g{HB, Win_t, MR, NINP, 2048, 2048, 2048}; pg8::StaticOrder S; S.init(MR, NINP, F.G, (int)blockIdx.x);
              pg8::EpiP E{P, NINP, ssq_kv, ssq_q};
              pg8::gemm_phase<pg8::EpiP, pg8::StaticOrder, true, true>(F.lds + RING_OFF, g, S, E); }
            { const int Mc = TT - MR; pg8::Gemm g{HB + (size_t)TL * DM, Win_t, Mc, 512, 2048, 2048, 2048}; pg8::StaticOrder S; S.init(Mc, 512, F.G, (int)blockIdx.x);
              pg8::EpiP E{P + (size_t)TL * NINP, NINP, ssq_kv + TL, ssq_q + TL};
              pg8::gemm_phase<pg8::EpiP, pg8::StaticOrder, true, true>(F.lds + RING_OFF, g, S, E); }
        }
        SEAM(pb + 0);
        if (EN(3) && IN(pb + 1)) { PHASE_BEGIN();
            LAYER_W(); LAYER_SSQ(); const bf16* Wq_t = (const bf16*)((char*)wl + WO_Q); const bf16* Wkv_t = (const bf16*)((char*)wl + WO_KV);
            bf16* P = WSP(bf16, WS_P); bf16* KN = WSP(bf16, WS_KN); bf16* VA = WSP(bf16, WS_VA); bf16* QR = WSP(bf16, WS_QR);
            { pg8::Gemm g{P, Wkv_t, TT, 4096, 256, NINP, 256}; pg8::StaticOrder S; S.init(TT, 4096, F.G, (int)blockIdx.x);
              pg8::EpiKV E{KN, VA, ssq_kv, 0};
              pg8::gemm_phase<pg8::EpiKV, pg8::StaticOrder, true, true>(F.lds + RING_OFF, g, S, E); }
            { pg8::Gemm g{P + PC_Q, Wq_t, MR, 3072, 512, NINP, 512}; pg8::StaticOrder S; S.init(MR, 3072, F.G, (int)blockIdx.x);
              pg8::EpiQ E{QR, ssq_q};
              pg8::gemm_phase<pg8::EpiQ, pg8::StaticOrder, true, true>(F.lds + RING_OFF, g, S, E); }
        }
        SEAM(pb + 1);
        if (EN(4) && IN(pb + 2)) { PHASE_BEGIN();
            const float* q_norm = INP(12); const float* k_norm = INP(13); const float* conv_w = INP(14); const float2* ROPE = WSP(float2, WS_ROPE);
            bf16* P = WSP(bf16, WS_P); bf16* KN = WSP(bf16, WS_KN); bf16* KA = WSP(bf16, WS_KA); bf16* QR = WSP(bf16, WS_QR); bf16* CV = WSP(bf16, WS_HB);
            for (int row_ = gw; row_ < TT; row_ += NGW) { int row = row_; asm volatile("" : "+s"(row)); qk_norm_row<0>(row, KN, P, KA, QR, k_norm + l * 192, ROPE, Fp.lane); }
            for (int row_ = gw; row_ < MR; row_ += NGW) { int row = row_; asm volatile("" : "+s"(row)); qk_norm_row<1>(row, KN, P, KA, QR, q_norm + l * 192, ROPE, Fp.lane); }
            for (int i = gt; i < MR * 256; i += NGT) conv_item(P, conv_w + (size_t)l * 3 * 2048, CV, i >> 8, (i & 255) * 8);
        }
        SEAM(pb + 2);
        if (EN(5) && IN(pb + 3)) { PHASE_BEGIN();
            const bf16* KA = WSP(bf16, WS_KA); const bf16* VA = WSP(bf16, WS_VA); const bf16* QR = WSP(bf16, WS_QR); bf16* ATT = WSP(bf16, WS_KN);
            const int NU = 1024 + ((l == 0) ? 64 : 0);
            for (int i = 0;; ++i) { const int u = i * F.G + F.vcu; if (u >= NU) break;
                if (u < 1024) { const int b = u >> 8, h = (u >> 4) & 15, qb = u & 15;
                    att::attn_unit(QR + (size_t)(b * SEQ + qb * 256) * 3072 + h * 192, KA + (size_t)(b * KEYS) * 3072 + h * 192, VA + (size_t)(b * KEYS) * 2048 + h * 128,
                                   ATT + (size_t)(b * SEQ + qb * 256) * 2048 + h * 128, KEYS, (char*)lds + RING_OFF); }
                else { const int uc = u - 1024, b = uc >> 4, h = uc & 15;
                    att::attn_unit(QR + (size_t)(TL + b * CTXL) * 3072 + h * 192, KA + (size_t)(b * KEYS + SEQ) * 3072 + h * 192, VA + (size_t)(b * KEYS + SEQ) * 2048 + h * 128,
                                   ATT + (size_t)(TL + b * CTXL) * 2048 + h * 128, CTXL, (char*)lds + RING_OFF); } }
        }
        SEAM(pb + 3);
        if (EN(6) && IN(pb + 4)) { PHASE_BEGIN();
            LAYER_W(); const bf16* Wa_t = (const bf16*)((char*)wl + WO_A); const bf16* Wc_t = (const bf16*)((char*)wl + WO_C);
            const bf16* P = WSP(bf16, WS_P); const bf16* ATT = WSP(bf16, WS_KN); const bf16* CV = WSP(bf16, WS_HB); bf16* Y1 = WSP(bf16, WS_KA); bf16* MB = WSP(bf16, WS_VA);
            { pg8::Gemm g{ATT, Wa_t, MR, 2048, 2048, 2048, 2048}; pg8::StaticOrder S; S.init(MR, 2048, F.G, (int)blockIdx.x);
              pg8::EpiGate<false> E{Y1, nullptr, P + PC_GA, NINP};
              pg8::gemm_phase<pg8::EpiGate<false>, pg8::StaticOrder, true, true>(F.lds + RING_OFF, g, S, E); }
            { pg8::Gemm g{CV, Wc_t, MR, 2048, 2048, 2048, 2048}; pg8::StaticOrder S; S.init(MR, 2048, F.G, (int)blockIdx.x);
              pg8::EpiGate<true> E{MB, Y1, P + PC_GB, NINP};
              pg8::gemm_phase<pg8::EpiGate<true>, pg8::StaticOrder, true, true>(F.lds + RING_OFF, g, S, E); }
        }
        SEAM(pb + 4);
        if (EN(7) && IN(pb + 5)) { PHASE_BEGIN();
            LAYER_W(); LAYER_ADA(); const bf16* Wo_t = (const bf16*)((char*)wl + WO_O); const bf16* MB = WSP(bf16, WS_VA); float* CTXB = WSP(float, WS_CTXB);
            const float* x_in = INP(0); const float* ctx_in = INP(2);
            pg8::Gemm g{MB, Wo_t, MR, 2048, 2048, 2048, 2048}; pg8::StaticOrder S; S.init(MR, 2048, F.G, (int)blockIdx.x);
            pg8::EpiRes E{l == 0 ? x_in : xout, xout, ada_l, ctx_in, CTXB};
            pg8::gemm_phase<pg8::EpiRes, pg8::StaticOrder, true, true>(F.lds + RING_OFF, g, S, E);
        }
        SEAM(pb + 5);
        if (EN(8) && IN(pb + 6)) { PHASE_BEGIN();
            LAYER_ADA(); const float* ln_ffn = INP(18); const float* u_exp = INP(21); const float* v_exp = INP(22); float* CTXB = WSP(float, WS_CTXB); bf16* HB = WSP(bf16, WS_HB);
            unsigned char* UB = WSP(unsigned char, WS_UB); unsigned char* VB = WSP(unsigned char, WS_VB); float* USC = WSP(float, WS_USC); float* VSC = WSP(float, WS_VSC);
            for (int row_ = gw; row_ < MR; row_ += NGW) { int row = row_; asm volatile("" : "+s"(row)); const int bi = row_bi(row); const float* ap = ada_l + (size_t)bi * 12288;
                norm_mod_row(row < TL ? xout + (size_t)row * DM : CTXB + (size_t)(row - TL) * DM, ln_ffn + l * DM, ap + 3 * 2048, ap + 4 * 2048, HB + (size_t)row * DM, Fp.lane); }
            const float* us = u_exp + (size_t)l * NEXP * DM; const float* vs = v_exp + (size_t)l * NEXP * DM;
            for (int r_ = gw; r_ < 2 * NEXP; r_ += NGW) { int r = r_; asm volatile("" : "+s"(r)); const bool isv = r >= NEXP; const int e = isv ? r - NEXP : r;
                fp8_row((isv ? vs : us) + (size_t)e * DM, (isv ? VB : UB) + (size_t)e * DM, (isv ? VSC : USC) + e, Fp.lane); }
        }
        SEAM(pb + 6);
        if (EN(9) && IN(pb + 7)) { PHASE_BEGIN();
            LAYER_W(); const bf16* Weff_t = (const bf16*)((char*)wl + WO_EFF); const bf16* HB = WSP(bf16, WS_HB); float* SC = WSP(float, WS_P);
            pg8::Gemm g{HB, Weff_t, MR, 2048, 2048, 2048, 2048}; pg8::StaticOrder S; S.init(MR, 2048, F.G, (int)blockIdx.x);
            pg8::EpiF32 E{SC, 2048};
            pg8::gemm_phase<pg8::EpiF32, pg8::StaticOrder, true, true>(F.lds + RING_OFF, g, S, E);
        }
        SEAM(pb + 7);
        if (EN(10) && IN(pb + 8)) { PHASE_BEGIN();
            const float* SC = WSP(float, WS_P); int* IDX = WSP(int, WS_IDX); float* GW = WSP(float, WS_GW);
            LAS int* lists = (LAS int*)(F.lds + RING_OFF + F.wave * 8192);
            for (int it_ = gw; it_ < MR / 8; it_ += NGW) { int it = it_; asm volatile("" : "+s"(it)); topk_item(SC, IDX, GW, it * 8, lists, Fp.lane); }
        }
        SEAM(pb + 8);
        if (EN(11) && IN(pb + 9)) { PHASE_BEGIN();
            LAYER_ADA(); const float* ln_mix = INP(6); const float* ADA = WSP(float, WS_ADA); float* CTXB = WSP(float, WS_CTXB); bf16* HB = WSP(bf16, WS_HB);
            const int* IDX = WSP(int, WS_IDX); const float* GW = WSP(float, WS_GW); const unsigned char* UB = WSP(unsigned char, WS_UB); const unsigned char* VB = WSP(unsigned char, WS_VB); const float* USC = WSP(float, WS_USC); const float* VSC = WSP(float, WS_VSC);
            for (int row_ = gw; row_ < MR; row_ += NGW) { int row = row_; asm volatile("" : "+s"(row));
                float o[32];
                peer_row(HB + (size_t)row * DM, IDX + (size_t)row * 128, GW + (size_t)row * 128, UB, VB, USC, VSC, o, Fp.lane);
                const int bi = row_bi(row); const float* g2 = ada_l + (size_t)bi * 12288 + 5 * 2048;
                float* xr = (row < TL) ? xout + (size_t)row * DM : CTXB + (size_t)(row - TL) * DM;
                float s = 0.f; const unsigned l64 = (unsigned)Fp.lane * 64u, l32 = (unsigned)Fp.lane * 32u;
#pragma unroll
                for (int j = 0; j < 2; ++j)
#pragma unroll
                    for (int q = 0; q < 4; ++q) { const unsigned off = l64 + j * 4096 + q * 16;
                        const f32x4 a = ldu<f32x4>(xr, off), ga = ldu<f32x4>(g2, off); f32x4 na;
#pragma unroll
                        for (int c = 0; c < 4; ++c) { na[c] = a[c] + ga[c] * o[16 * j + 4 * q + c]; o[16 * j + 4 * q + c] = na[c]; s += na[c] * na[c]; }
                        stu<f32x4>(xr, off, na); }
                if (l + 1 < NLAYER) {
                    const float r = __builtin_amdgcn_rsqf(wave_sum(s) * (1.0f / 2048.0f) + pg8::RMS_EPS);
                    const float* gain = ln_mix + (l + 1) * DM; const float* ap = ADA + ((size_t)(l + 1) * 5 + bi) * 12288;
#pragma unroll
                    for (int j = 0; j < 2; ++j) { float y[16];
#pragma unroll
                        for (int q = 0; q < 4; ++q) { const unsigned off = l64 + j * 4096 + q * 16;
                            const f32x4 g0 = ldu<f32x4>(gain, off), s0 = ldu<f32x4>(ap + 2048, off), h0 = ldu<f32x4>(ap, off);
#pragma unroll
                            for (int c = 0; c < 4; ++c) y[4 * q + c] = (o[16 * j + 4 * q + c] * r * g0[c]) * (s0[c] + 1.0f) + h0[c]; }
                        v4u w0, w1; w0.x = pk2(y[0], y[1]); w0.y = pk2(y[2], y[3]); w0.z = pk2(y[4], y[5]); w0.w = pk2(y[6], y[7]); w1.x = pk2(y[8], y[9]); w1.y = pk2(y[10], y[11]); w1.z = pk2(y[12], y[13]); w1.w = pk2(y[14], y[15]);
                        stu<v4u>(HB + (size_t)row * DM, l32 + j * 2048, w0); stu<v4u>(HB + (size_t)row * DM, l32 + j * 2048 + 16, w1); }
                }
            }
        }
        SEAM(pb + 9);
    }
#undef IN
#undef SEAM
}

#ifndef MK_N_LAUNCHES
#define MK_N_LAUNCHES 1
#endif
extern "C" void kernel_launch(void* const* d_in, const int* in_sizes, int n_in, void* d_out, int out_size, void* d_ws, size_t ws_size, hipStream_t stream) {
    static int grid = 0;
    if (grid == 0) {
        if (n_in != 23 || out_size != TL * DM || ws_size < WS_END) { fprintf(stderr, "kernel_launch: shape/workspace mismatch (n_in %d out %d ws %zu need %zu)\n", n_in, out_size, ws_size, (size_t)WS_END); grid = -1; return; }
        int dev = 0, cus = 0;
        if (hipGetDevice(&dev) != hipSuccess || hipDeviceGetAttribute(&cus, hipDeviceAttributeMultiprocessorCount, dev) != hipSuccess) { grid = -1; return; }
        if (hipFuncSetAttribute((const void*)fwd_kernel, hipFuncAttributeMaxDynamicSharedMemorySize, LDS_BYTES) != hipSuccess) { fprintf(stderr, "kernel_launch: hipFuncSetAttribute failed\n"); grid = -1; return; }
        int per_cu = 0;
        if (hipOccupancyMaxActiveBlocksPerMultiprocessor(&per_cu, (const void*)fwd_kernel, NWAVES * 64, LDS_BYTES) != hipSuccess || per_cu < 1) { fprintf(stderr, "kernel_launch: occupancy query reports %d\n", per_cu); (void)hipGetLastError(); }
        grid = cus;
    }
    if (grid < 0) return;
    if (hipMemsetAsync((char*)d_ws + WS_CTL, 0, CTL_ZERO_BYTES, stream) != hipSuccess) return;
    Args a{};
    for (int i = 0; i < 23; ++i) a.in[i] = (const float*)d_in[i];
    a.out = (float*)d_out; a.ws = (unsigned char*)d_ws;
#if MK_N_LAUNCHES == 1
    a.ph_lo = 0; a.ph_hi = NPHASE; a.li = 0;
    hipLaunchKernelGGL(fwd_kernel, dim3(grid), dim3(NWAVES * 64), LDS_BYTES, stream, a);
#else
    for (int p = 0; p < NPHASE; ++p) { a.ph_lo = p; a.ph_hi = p + 1; a.li = p; hipLaunchKernelGGL(fwd_kernel, dim3(grid), dim3(NWAVES * 64), LDS_BYTES, stream, a); }
#endif
}
```
